# Optimizing an MI355X kernel written in HIP

```python
import math
import jax, jax.numpy as jnp
from jax import lax
import numpy as np

D_MODEL = 2048
BATCH = 1
SEQ = 16384
DEPTH = 1
DEC_BATCH = 8
DEC_SEQ = 2048
PAST_LEN = 128

MLA_HEADS = 8
MLA_NOPE = 128
MLA_ROPE = 64
MLA_QK = MLA_NOPE + MLA_ROPE
MLA_V = 128
Q_LORA = 512
KV_LORA = 256
ROPE_THETA = 10000.0
MLA_OUT = MLA_HEADS * MLA_V
DIFF_HEADS = 8
DIFF_QK = 64
DIFF_V = 2 * DIFF_QK
DIFF_OUT = DIFF_HEADS * DIFF_V
REL_BUCKETS = 32
REL_MAX_DIST = 128
D_FF = -(-(8 * D_MODEL) // (3 * 256)) * 256
Q_BLOCK = 128
EPS = 1e-6
COL_SIZES = (Q_LORA, KV_LORA, MLA_ROPE,
             DIFF_HEADS * 2 * DIFF_QK, DIFF_HEADS * 2 * DIFF_QK, DIFF_OUT,
             D_MODEL, D_MODEL)
D_IN = sum(COL_SIZES)

kernel_name = "hybrid_mla_diffattn_gated_encoder"


def _split_points():
    pts, acc = [], 0
    for s in COL_SIZES[:-1]:
        acc += s
        pts.append(acc)
    return pts


def rmsnorm(x, g):
    xf = x.astype(jnp.float32)
    y = xf * lax.rsqrt(jnp.mean(xf * xf, axis=-1, keepdims=True) + EPS)
    return (y * g.astype(jnp.float32)).astype(x.dtype)


def rope(x, pos):
    half = x.shape[-1] // 2
    inv = ROPE_THETA ** (-jnp.arange(half, dtype=jnp.float32) / half)
    ang = pos[:, None].astype(jnp.float32) * inv[None, :]
    cos = jnp.cos(ang)[None, :, None, :].astype(x.dtype)
    sin = jnp.sin(ang)[None, :, None, :].astype(x.dtype)
    x1, x2 = x[..., :half], x[..., half:]
    return jnp.concatenate([x1 * cos - x2 * sin, x2 * cos + x1 * sin], axis=-1)


def t5_bucket(rel):
    nb = REL_BUCKETS // 2
    ret = jnp.where(rel > 0, nb, 0)
    n = jnp.abs(rel)
    max_exact = nb // 2
    nf = jnp.maximum(n, 1).astype(jnp.float32)
    large = max_exact + (jnp.log(nf / max_exact) / math.log(REL_MAX_DIST / max_exact)
                         * (nb - max_exact)).astype(jnp.int32)
    large = jnp.minimum(large, nb - 1)
    return ret + jnp.where(n < max_exact, n, large)


def mla_attend(q, k, v):
    B, S, H, D = q.shape
    nb = S // Q_BLOCK
    qb = q.reshape(B, nb, Q_BLOCK, H, D).swapaxes(0, 1)
    scale = D ** -0.5

    def blk(qi):
        s = jnp.einsum('bqhd,bkhd->bhqk', qi, k).astype(jnp.float32) * scale
        p = jax.nn.softmax(s, axis=-1)
        return jnp.einsum('bhqk,bkhd->bqhd', p.astype(v.dtype), v)

    o = lax.map(blk, qb)
    return o.swapaxes(0, 1).reshape(B, S, H * v.shape[-1])


def diff_attend(q, k, v, lam, rel_bias):
    B, S, H, _, D = q.shape
    nb = S // Q_BLOCK
    qb = q.reshape(B, nb, Q_BLOCK, H, 2, D).swapaxes(0, 1)
    kpos = jnp.arange(S, dtype=jnp.int32)
    scale = D ** -0.5

    def blk(args):
        qi, i = args
        qpos = i * Q_BLOCK + jnp.arange(Q_BLOCK, dtype=jnp.int32)
        bias = rel_bias[t5_bucket(kpos[None, :] - qpos[:, None])]
        bias = jnp.transpose(bias, (2, 0, 1)).astype(jnp.float32)[None, :, None]
        s = jnp.einsum('bqhmd,bkhmd->bhmqk', qi, k).astype(jnp.float32) * scale + bias
        p = jax.nn.softmax(s, axis=-1)
        a = p[:, :, 0] - lam * p[:, :, 1]
        return jnp.einsum('bhqk,bkhd->bqhd', a.astype(v.dtype), v)

    o = lax.map(blk, (qb, jnp.arange(nb, dtype=jnp.int32)))
    return o.swapaxes(0, 1).reshape(B, S, H, v.shape[-1])


def encoder_layer(x, l, p, rel_bias):
    B, S, _ = x.shape
    pos = jnp.arange(S, dtype=jnp.int32)
    h = rmsnorm(x, p['mix_norm'][l])
    z = h @ p['w_in'][l]
    c_q, c_kv, k_pe, dq, dk, dv, g_a, g_b = jnp.split(z, _split_points(), axis=-1)

    q = (rmsnorm(c_q, p['q_a_norm'][l]) @ p['wq_b'][l]).reshape(B, S, MLA_HEADS, MLA_QK)
    kv = (rmsnorm(c_kv, p['kv_a_norm'][l]) @ p['wkv_b'][l]).reshape(B, S, MLA_HEADS, MLA_NOPE + MLA_V)
    k_nope, v_a = kv[..., :MLA_NOPE], kv[..., MLA_NOPE:]
    k_pe = jnp.broadcast_to(k_pe[:, :, None, :], (B, S, MLA_HEADS, MLA_ROPE))
    k = jnp.concatenate([k_nope, k_pe], axis=-1)
    q = rmsnorm(q, p['mla_q_norm'][l])
    k = rmsnorm(k, p['mla_k_norm'][l])
    q = jnp.concatenate([q[..., :MLA_NOPE], rope(q[..., MLA_NOPE:], pos)], axis=-1)
    k = jnp.concatenate([k[..., :MLA_NOPE], rope(k[..., MLA_NOPE:], pos)], axis=-1)
    o_a = mla_attend(q, k, v_a)

    lam_init = 0.8 - 0.6 * math.exp(-0.3 * l)
    lam = (jnp.exp(jnp.sum(p['lambda_q1'][l].astype(jnp.float32) * p['lambda_k1'][l].astype(jnp.float32)))
           - jnp.exp(jnp.sum(p['lambda_q2'][l].astype(jnp.float32) * p['lambda_k2'][l].astype(jnp.float32)))
           + lam_init)
    qd = rmsnorm(dq.reshape(B, S, DIFF_HEADS, 2, DIFF_QK), p['diff_q_norm'][l])
    kd = rmsnorm(dk.reshape(B, S, DIFF_HEADS, 2, DIFF_QK), p['diff_k_norm'][l])
    vd = dv.reshape(B, S, DIFF_HEADS, DIFF_V)
    o_b = diff_attend(qd, kd, vd, lam, rel_bias)
    o_b = (rmsnorm(o_b, p['diff_subln'][l]) * (1.0 - lam_init)).reshape(B, S, DIFF_OUT)

    merged = (jax.nn.sigmoid(g_a) * (o_a @ p['w_up_mla'][l])
              + jax.nn.sigmoid(g_b) * (o_b @ p['w_up_diff'][l]))
    x = x + merged @ p['w_o'][l]

    h = rmsnorm(x, p['ffn_norm'][l])
    x = x + (jax.nn.silu(h @ p['w_gate'][l]) * (h @ p['w_up'][l])) @ p['w_down'][l]
    return x


def setup_inputs(seed: int = 0) -> dict:
    key = jax.random.key(seed)
    ks = jax.random.split(key, 32)
    f32 = jnp.float32

    def w(k, shape, fan_in):
        return jax.random.normal(k, shape, f32) * fan_in ** -0.5

    def g(k, shape):
        return 1.0 + 0.02 * jax.random.normal(k, shape, f32)

    L = DEPTH
    return {
        'x_prompt': jax.random.normal(ks[0], (BATCH, SEQ, D_MODEL), f32),
        'x_sample': jax.random.normal(ks[1], (DEC_BATCH, DEC_SEQ, D_MODEL), f32),
        'mix_norm': g(ks[2], (L, D_MODEL)),
        'w_in': w(ks[3], (L, D_MODEL, D_IN), D_MODEL),
        'q_a_norm': g(ks[4], (L, Q_LORA)),
        'wq_b': w(ks[5], (L, Q_LORA, MLA_HEADS * MLA_QK), Q_LORA),
        'kv_a_norm': g(ks[6], (L, KV_LORA)),
        'wkv_b': w(ks[7], (L, KV_LORA, MLA_HEADS * (MLA_NOPE + MLA_V)), KV_LORA),
        'mla_q_norm': g(ks[8], (L, MLA_QK)),
        'mla_k_norm': g(ks[9], (L, MLA_QK)),
        'diff_q_norm': g(ks[10], (L, DIFF_QK)),
        'diff_k_norm': g(ks[11], (L, DIFF_QK)),
        'lambda_q1': 0.1 * jax.random.normal(ks[12], (L, DIFF_QK), f32),
        'lambda_k1': 0.1 * jax.random.normal(ks[13], (L, DIFF_QK), f32),
        'lambda_q2': 0.1 * jax.random.normal(ks[14], (L, DIFF_QK), f32),
        'lambda_k2': 0.1 * jax.random.normal(ks[15], (L, DIFF_QK), f32),
        'diff_subln': g(ks[16], (L, DIFF_V)),
        'w_up_mla': w(ks[17], (L, MLA_OUT, D_MODEL), MLA_OUT),
        'w_up_diff': w(ks[18], (L, DIFF_OUT, D_MODEL), DIFF_OUT),
        'w_o': w(ks[19], (L, D_MODEL, D_MODEL), D_MODEL),
        'ffn_norm': g(ks[20], (L, D_MODEL)),
        'w_gate': w(ks[21], (L, D_MODEL, D_FF), D_MODEL),
        'w_up': w(ks[22], (L, D_MODEL, D_FF), D_MODEL),
        'w_down': w(ks[23], (L, D_FF, D_MODEL), D_FF),
        'rel_bias': 0.5 * jax.random.normal(ks[24], (REL_BUCKETS, DIFF_HEADS), f32),
    }


def reference(x_prompt, x_sample, mix_norm, w_in, q_a_norm, wq_b, kv_a_norm, wkv_b,
              mla_q_norm, mla_k_norm, diff_q_norm, diff_k_norm, lambda_q1, lambda_k1,
              lambda_q2, lambda_k2, diff_subln, w_up_mla, w_up_diff, w_o, ffn_norm,
              w_gate, w_up, w_down, rel_bias):
    p = dict(mix_norm=mix_norm, w_in=w_in, q_a_norm=q_a_norm, wq_b=wq_b,
             kv_a_norm=kv_a_norm, wkv_b=wkv_b, mla_q_norm=mla_q_norm, mla_k_norm=mla_k_norm,
             diff_q_norm=diff_q_norm, diff_k_norm=diff_k_norm, lambda_q1=lambda_q1,
             lambda_k1=lambda_k1, lambda_q2=lambda_q2, lambda_k2=lambda_k2,
             diff_subln=diff_subln, w_up_mla=w_up_mla, w_up_diff=w_up_diff, w_o=w_o,
             ffn_norm=ffn_norm, w_gate=w_gate, w_up=w_up, w_down=w_down)
    y_prompt = x_prompt
    y_sample = x_sample
    for l in range(DEPTH):
        y_prompt = encoder_layer(y_prompt, l, p, rel_bias)
        y_sample = encoder_layer(y_sample, l, p, rel_bias)
    return (y_prompt, y_sample)
```

```cpp
#include <hip/hip_runtime.h>
#include <hip/hip_cooperative_groups.h>
#include <cstdio>
#include <cstdint>
namespace cg = cooperative_groups;

#define LAS __attribute__((address_space(3)))
typedef unsigned short bf16_t;
typedef short bf16x8 __attribute__((ext_vector_type(8)));
typedef short s16x4 __attribute__((ext_vector_type(4)));
typedef float f32x2 __attribute__((ext_vector_type(2)));
typedef float f32x4 __attribute__((ext_vector_type(4)));
typedef float f32x16 __attribute__((ext_vector_type(16)));
typedef unsigned u32x2 __attribute__((ext_vector_type(2)));
typedef unsigned u32x4 __attribute__((ext_vector_type(4)));

#define DBG_S 41
#ifndef PROBE_MLA
#define PROBE_MLA 0
#endif
#ifndef PROBE_P4
#define PROBE_P4 0
#endif
#ifndef MK_XCD_BARRIER
#define MK_XCD_BARRIER 1
#endif
#ifndef MK_ONE_LAUNCH
#define MK_ONE_LAUNCH 1
#endif

constexpr int T = 32768, TP = 16384, SSEQ = 2048, DM = 2048, DFF = 5632;
constexpr float EPS = 1e-6f, LOG2E = 1.4426950408889634f;
constexpr float SC_MLA = 0.07216878364870322f * LOG2E;
constexpr float SC_DIFF = 0.125f * LOG2E;
constexpr int NCHUNK = 2, TC = T / NCHUNK;

constexpr size_t MiB = 1u << 20;
constexpr size_t WS_SSQ = 0, WS_SSKV = 128 * 1024, WS_SSPE = 256 * 1024, WS_SS2 = 384 * 1024, WS_LUT = 512 * 1024, WS_LAM = 640 * 1024;
constexpr size_t WS_ROPE = 8 * MiB, WS_BAR = 1 * MiB;
constexpr size_t WS_WIN1 = 12 * MiB, WS_CQ = 28 * MiB, WS_CKV = 60 * MiB, WS_OA = 12 * MiB;
constexpr size_t WS_KPE = 76 * MiB, WS_WG = 84 * MiB, WS_WQB = 100 * MiB, WS_WKVB = 102 * MiB, WS_WUPM = 103 * MiB, WS_WUPD = 107 * MiB;
constexpr size_t WS_WO = 111 * MiB, WS_WGU = 119 * MiB, WS_WDN = 163 * MiB, WS_H = 185 * MiB;
constexpr size_t WS_QD = 313 * MiB, WS_KD = 377 * MiB, WS_VD = 441 * MiB, WS_END = 505 * MiB;
constexpr size_t WS_MERGED = WS_KD, WS_ACT = WS_QD;
constexpr size_t DO_QM = 0, DO_KM = 96 * MiB, DO_VM = 192 * MiB;

constexpr int LDS_RED = 131072;
constexpr int LDS_WSCR = 131072 + 4096;
constexpr int LDS_LUT = LDS_WSCR + 2048;
constexpr int LDS_XB = LDS_LUT + 1280;
constexpr int LDS_BYTES = 147456;

typedef __bf16 bf16x2_t __attribute__((ext_vector_type(2)));
__device__ __forceinline__ unsigned cvtpk(float lo, float hi) { f32x2 v = {lo, hi}; bf16x2_t b = __builtin_convertvector(v, bf16x2_t); return __builtin_bit_cast(unsigned, b); }
__device__ __forceinline__ float bf2f(unsigned short b) { return __uint_as_float(((unsigned)b) << 16); }
__device__ __forceinline__ u32x4 pack8(f32x4 a, f32x4 b) { u32x4 w; w.x = cvtpk(a[0], a[1]); w.y = cvtpk(a[2], a[3]); w.z = cvtpk(b[0], b[1]); w.w = cvtpk(b[2], b[3]); return w; }
__device__ __forceinline__ void unpack8(u32x4 w, f32x4& a, f32x4& b) {
    a[0] = __uint_as_float(w.x << 16); a[1] = __uint_as_float(w.x & 0xffff0000u); a[2] = __uint_as_float(w.y << 16); a[3] = __uint_as_float(w.y & 0xffff0000u);
    b[0] = __uint_as_float(w.z << 16); b[1] = __uint_as_float(w.z & 0xffff0000u); b[2] = __uint_as_float(w.w << 16); b[3] = __uint_as_float(w.w & 0xffff0000u); }
__device__ __forceinline__ float dot4(f32x4 a) { return (a[0] * a[0] + a[1] * a[1]) + (a[2] * a[2] + a[3] * a[3]); }
__device__ __forceinline__ float sigmoidf_(float x) { return __builtin_amdgcn_rcpf(1.f + __builtin_amdgcn_exp2f(-x * LOG2E)); }
__device__ __forceinline__ int posof(int row) { return row < TP ? row : (row & (SSEQ - 1)); }

namespace pg8 {
constexpr int BM = 256, BK = 64, HALF = 128, HTB = HALF * BK * 2, STAGE_BYTES = 8 * HTB, NXCD = 8, WGM = 8;
__host__ __device__ __forceinline__ int lds_byte(int r, int c) { const int st = (r >> 4) * 2 + (c >> 5), rr = r & 15, cc = c & 31, ob = rr * 64 + cc * 2; return st * 1024 + (ob ^ (((ob >> 9) & 1) << 5)); }
__host__ __device__ __forceinline__ void stage_rc(int b, int& R, int& C) { const int st = b / 1024, sb = b % 1024, swz = sb ^ (((sb >> 9) & 1) << 5); R = (st >> 1) * 16 + swz / 64; C = (st & 1) * 32 + (swz % 64) / 2; }
__host__ __device__ __forceinline__ int perm32(int rho) { const int n = rho >> 4, i = rho & 15; return 8 * (i >> 2) + 4 * n + (i & 3); }

struct Unit { int pm, pn, sub; };
struct Gemm { const bf16_t* A0; const bf16_t* A1; const bf16_t* B0; const bf16_t* B1; int K; };

struct StaticOrder {
    int nM, nN, nwg, G, c, nsub;
    __device__ void init(int M, int N, int G_, int c_, int nsub_ = 1) { nM = M / BM; nN = N / BM; nwg = nM * nN; G = G_; c = c_; nsub = nsub_; }
    __device__ bool next(int i, Unit& u) const {
        const int it = (nsub == 2) ? (i >> 1) : i; u.sub = (nsub == 2) ? (i & 1) : 0;
        const long L = (long)it * G + c; if (L >= nwg) return false;
        int wgid = (int)L; { const int q = nwg / NXCD, r = nwg % NXCD, xcd = wgid % NXCD, off = wgid / NXCD; wgid = (xcd < r ? xcd * (q + 1) : r * (q + 1) + (xcd - r) * q) + off; }
        const int nig = WGM * nN, gid = wgid / nig, fm = gid * WGM, gsz = (nM - fm) < WGM ? (nM - fm) : WGM;
        u.pm = fm + ((wgid % nig) % gsz); u.pn = (wgid % nig) / gsz; return true;
    }
};

template <class Epi, class Sched>
__device__ __forceinline__ void gemm_phase(LAS unsigned char* lds, const Gemm g, const Sched& S, const Epi& E) {
    int tid_ = threadIdx.x; asm volatile("" : "+v"(tid_));
    const int tid = tid_, wid = __builtin_amdgcn_readfirstlane(tid >> 6), lane = tid & 63, wr = wid >> 2, wc = wid & 3, fr = lane & 15, fq = lane >> 4;
    const int K = g.K, nt = K / BK;
    unsigned voffA[2], voffB[2];
#pragma unroll
    for (int i = 0; i < 2; ++i) { int R, C; stage_rc(tid * 16 + i * 8192, R, C); const int Rb = (R & ~31) + perm32(R & 31);
        voffA[i] = (unsigned)(R * K + C) * 2u; voffB[i] = (unsigned)(Rb * K + C) * 2u; }
    const size_t kstep = (size_t)(BK * 2);
    const size_t hstep = (size_t)HALF * K * 2;
    const size_t tstep = 2 * hstep;
    const unsigned ldsw = (unsigned)wid * 1024u;
    const int aoff = lds_byte(wr * 64 + fr, fq * 8), boff = lds_byte(wc * 32 + fr, fq * 8);
#define PG8_SA(b, h) (((b) * 2 + (h)) * HTB)
#define PG8_SB(b, h) ((4 + (b) * 2 + (h)) * HTB)
#define PG8_STAGE(bufoff, gbase, voff) do { _Pragma("unroll") for (int _i = 0; _i < 2; ++_i) \
        __builtin_amdgcn_global_load_lds((const unsigned*)((const char*)(gbase) + (voff)[_i]), (LAS unsigned*)(lds + (bufoff) + ldsw + _i * 8192), 16, 0, 0); } while (0)
#define PG8_LDA(dst, b, h) do { _Pragma("unroll") for (int m = 0; m < 4; ++m) _Pragma("unroll") for (int k = 0; k < 2; ++k) dst[m][k] = *(const LAS bf16x8*)(lds + PG8_SA(b, h) + aoff + m * 2048 + k * 1024); } while (0)
#define PG8_LDB(dst, b, h) do { _Pragma("unroll") for (int n = 0; n < 2; ++n) _Pragma("unroll") for (int k = 0; k < 2; ++k) dst[n][k] = *(const LAS bf16x8*)(lds + PG8_SB(b, h) + boff + n * 2048 + k * 1024); } while (0)
#define PG8_MMA(ai, bj, At, Bt) do { __builtin_amdgcn_s_setprio(1); _Pragma("unroll") for (int m = 0; m < 4; ++m) _Pragma("unroll") for (int n = 0; n < 2; ++n) _Pragma("unroll") for (int k = 0; k < 2; ++k) \
        acc[ai][bj][m][n] = __builtin_amdgcn_mfma_f32_16x16x32_bf16(Bt[n][k], At[m][k], acc[ai][bj][m][n], 0, 0, 0); __builtin_amdgcn_s_setprio(0); } while (0)
#define PG8_WAIT_V(n) asm volatile("s_waitcnt vmcnt(" #n ")" ::: "memory")
#define PG8_WAIT_L(n) asm volatile("s_waitcnt lgkmcnt(" #n ")" ::: "memory")
#define PG8_BAR __builtin_amdgcn_s_barrier()
#define PG8_SCHED __builtin_amdgcn_sched_barrier(0)
    Unit cur, nxt; int ui = 0;
    if (!S.next(0, cur)) return;
    f32x4 acc[2][2][4][2];
#pragma unroll
    for (int a = 0; a < 2; ++a)
#pragma unroll
        for (int b = 0; b < 2; ++b)
#pragma unroll
            for (int m = 0; m < 4; ++m)
#pragma unroll
                for (int n = 0; n < 2; ++n) acc[a][b][m][n] = (f32x4){0.f, 0.f, 0.f, 0.f};
    bf16x8 At[4][2], B0[2][2], B1[2][2];
    const char* cA = (const char*)(cur.sub ? g.A1 : g.A0) + (size_t)cur.pm * tstep; const char* cB = (const char*)(cur.sub ? g.B1 : g.B0) + (size_t)cur.pn * tstep;
    PG8_STAGE(PG8_SB(0, 0), cB, voffB); PG8_STAGE(PG8_SB(0, 1), cB + hstep, voffB); PG8_STAGE(PG8_SA(0, 0), cA, voffA); PG8_STAGE(PG8_SA(0, 1), cA + hstep, voffA);
    if (wr == 1) PG8_BAR;
    PG8_WAIT_V(2); PG8_BAR;
    PG8_STAGE(PG8_SB(1, 0), cB + kstep, voffB); PG8_STAGE(PG8_SA(1, 0), cA + kstep, voffA); PG8_STAGE(PG8_SB(1, 1), cB + hstep + kstep, voffB);
    PG8_WAIT_V(6); PG8_BAR;
    for (;;) {
        const bool has_next = S.next(ui + 1, nxt);
        const char* nA = has_next ? (const char*)(nxt.sub ? g.A1 : g.A0) + (size_t)nxt.pm * tstep : cA; const char* nB = has_next ? (const char*)(nxt.sub ? g.B1 : g.B0) + (size_t)nxt.pn * tstep : cB;
#pragma unroll 1
        for (int t = 0; t < nt; t += 2) {
            const bool last = (t == nt - 2);
            const char* a1 = cA + (size_t)(t + 1) * kstep;
            const char* a2 = last ? nA : cA + (size_t)(t + 2) * kstep; const char* b2 = last ? nB : cB + (size_t)(t + 2) * kstep;
            const char* a3 = a2 + kstep; const char* b3 = b2 + kstep;
            PG8_LDB(B0, 0, 0); PG8_LDB(B1, 0, 1); PG8_SCHED; PG8_LDA(At, 0, 0); PG8_STAGE(PG8_SA(1, 1), a1 + hstep, voffA);
            PG8_WAIT_V(8); PG8_WAIT_L(0); PG8_BAR; PG8_MMA(0, 0, At, B0); PG8_MMA(0, 1, At, B1); PG8_BAR; PG8_SCHED;
            PG8_LDA(At, 0, 1); PG8_STAGE(PG8_SB(0, 0), b2, voffB); PG8_STAGE(PG8_SB(0, 1), b2 + hstep, voffB); PG8_STAGE(PG8_SA(0, 0), a2, voffA);
            PG8_WAIT_V(8); PG8_WAIT_L(0); PG8_BAR; PG8_MMA(1, 0, At, B0); PG8_MMA(1, 1, At, B1); PG8_BAR; PG8_SCHED;
            PG8_LDB(B0, 1, 0); PG8_LDB(B1, 1, 1); PG8_SCHED; PG8_LDA(At, 1, 0); PG8_STAGE(PG8_SA(0, 1), a2 + hstep, voffA);
            PG8_WAIT_V(8); PG8_WAIT_L(0); PG8_BAR; PG8_MMA(0, 0, At, B0); PG8_MMA(0, 1, At, B1); PG8_BAR; PG8_SCHED;
            PG8_LDA(At, 1, 1); PG8_STAGE(PG8_SB(1, 0), b3, voffB); PG8_STAGE(PG8_SB(1, 1), b3 + hstep, voffB); PG8_STAGE(PG8_SA(1, 0), a3, voffA);
            PG8_WAIT_V(8); PG8_WAIT_L(0); PG8_BAR; PG8_MMA(1, 0, At, B0); PG8_MMA(1, 1, At, B1); PG8_BAR; PG8_SCHED;
        }
        if (wr == 0) PG8_BAR;
        const bool keep = E(acc, cur, wr, wc, fr, fq);
        if (!has_next) break;
        if (!keep) {
#pragma unroll
        for (int a = 0; a < 2; ++a)
#pragma unroll
            for (int b = 0; b < 2; ++b)
#pragma unroll
                for (int m = 0; m < 4; ++m)
#pragma unroll
                    for (int n = 0; n < 2; ++n) acc[a][b][m][n] = (f32x4){0.f, 0.f, 0.f, 0.f};
        }
        cur = nxt; cA = nA; cB = nB; ++ui;
        if (wr == 1) PG8_BAR;
    }
    PG8_WAIT_V(0);
    PG8_BAR;
#undef PG8_SA
#undef PG8_SB
#undef PG8_STAGE
#undef PG8_LDA
#undef PG8_LDB
#undef PG8_MMA
#undef PG8_WAIT_V
#undef PG8_WAIT_L
#undef PG8_BAR
#undef PG8_SCHED
}
}
using pg8::Unit;
typedef f32x4 Acc[2][2][4][2];
#define EPI_BAR() do { asm volatile("s_waitcnt lgkmcnt(0)" ::: "memory"); __builtin_amdgcn_s_barrier(); asm volatile("" ::: "memory"); } while (0)

struct Epi1 {
    bf16_t *CQ, *CKV, *QD, *KD, *VD; float *KPE, *ssq, *sskv, *sspe; const float *gq, *gk;
    __device__ __forceinline__ bool operator()(Acc& acc, const Unit& u, int wr, int wc, int fr, int fq) const {
        const int pn = u.pn, row0 = u.pm * 256 + wr * 64 + fr;
        if (pn < 3 || pn >= 12) {
            bf16_t* base; int ld, colt; float* ss = nullptr;
            if (pn < 2) { base = CQ; ld = 512; colt = pn * 256; ss = ssq; } else if (pn == 2) { base = CKV; ld = 256; colt = 0; ss = sskv; } else { base = VD; ld = 1024; colt = (pn - 12) * 256; }
#pragma unroll
            for (int ai = 0; ai < 2; ++ai)
#pragma unroll
                for (int m = 0; m < 4; ++m) { const int row = row0 + ai * 128 + m * 16; float s = 0.f;
#pragma unroll
                    for (int bj = 0; bj < 2; ++bj) { const f32x4 v0 = acc[ai][bj][m][0], v1 = acc[ai][bj][m][1]; s += dot4(v0) + dot4(v1);
                        *(u32x4*)(base + (size_t)row * ld + colt + bj * 128 + wc * 32 + 8 * fq) = pack8(v0, v1); }
                    if (ss) { s += __shfl_xor(s, 16); s += __shfl_xor(s, 32); if (fq == 0) unsafeAtomicAdd(ss + row, s); } }
        } else if (pn == 3) {
            if (wc == 0) {
#pragma unroll
                for (int ai = 0; ai < 2; ++ai)
#pragma unroll
                    for (int m = 0; m < 4; ++m) { const int row = row0 + ai * 128 + m * 16; float s = 0.f;
#pragma unroll
                        for (int bj = 0; bj < 2; ++bj) { const f32x4 v0 = acc[ai][bj][m][0], v1 = acc[ai][bj][m][1]; s += dot4(v0) + dot4(v1);
                            float* p = KPE + (size_t)row * 64 + 32 * bj + 8 * fq; *(f32x4*)p = v0; *(f32x4*)(p + 4) = v1; }
                        s += __shfl_xor(s, 16); s += __shfl_xor(s, 32); if (fq == 0) sspe[row] = s; }
            }
        } else {
            const bool isq = pn < 8; bf16_t* base = isq ? QD : KD; const int colt = (pn - (isq ? 4 : 8)) * 256; const float* g = isq ? gq : gk; const float sc = isq ? SC_DIFF : 1.f;
            f32x4 gv[2][2];
#pragma unroll
            for (int bj = 0; bj < 2; ++bj)
#pragma unroll
                for (int n = 0; n < 2; ++n) gv[bj][n] = *(const f32x4*)(g + 32 * bj + 8 * fq + 4 * n);
#pragma unroll
            for (int ai = 0; ai < 2; ++ai)
#pragma unroll
                for (int m = 0; m < 4; ++m) { const int row = row0 + ai * 128 + m * 16; float s = 0.f;
#pragma unroll
                    for (int bj = 0; bj < 2; ++bj) s += dot4(acc[ai][bj][m][0]) + dot4(acc[ai][bj][m][1]);
                    s += __shfl_xor(s, 16); s += __shfl_xor(s, 32);
                    const float rs = rsqrtf(s * (1.f / 64.f) + EPS) * sc;
#pragma unroll
                    for (int bj = 0; bj < 2; ++bj) { const f32x4 v0 = acc[ai][bj][m][0] * rs * gv[bj][0], v1 = acc[ai][bj][m][1] * rs * gv[bj][1];
                        *(u32x4*)(base + (size_t)row * 1024 + colt + 64 * wc + 32 * bj + 8 * fq) = pack8(v0, v1); } }
        }
        return false;
    }
};
struct Epi2a {
    bf16_t* QM; const float* ssq; const float* gqn; const f32x2* rope; LAS float* red;
    __device__ __forceinline__ bool operator()(Acc& acc, const Unit& u, int wr, int wc, int fr, int fq) const {
        const int h = u.pn, rl0 = wr * 64 + fr;
        float ssv[2][4];
#pragma unroll
        for (int ai = 0; ai < 2; ++ai)
#pragma unroll
            for (int m = 0; m < 4; ++m) ssv[ai][m] = ssq[u.pm * 256 + rl0 + ai * 128 + m * 16];
#pragma unroll
        for (int ai = 0; ai < 2; ++ai)
#pragma unroll
            for (int m = 0; m < 4; ++m) { float s = 0.f;
#pragma unroll
                for (int bj = 0; bj < 2; ++bj) s += dot4(acc[ai][bj][m][0]) + dot4(acc[ai][bj][m][1]);
                s += __shfl_xor(s, 16); s += __shfl_xor(s, 32);
                if (fq == 0) red[(rl0 + ai * 128 + m * 16) * 4 + wc] = s; }
        EPI_BAR();
        if (wc < 3) {
            f32x4 gv[2][2];
#pragma unroll
            for (int bj = 0; bj < 2; ++bj)
#pragma unroll
                for (int n = 0; n < 2; ++n) gv[bj][n] = *(const f32x4*)(gqn + 64 * wc + 32 * bj + 8 * fq + 4 * n);
#pragma unroll
            for (int ai = 0; ai < 2; ++ai) {
#pragma unroll
              for (int mp = 0; mp < 2; ++mp) {
                f32x2 csv[2][8];
                if (wc == 2) {
#pragma unroll
                    for (int mm = 0; mm < 2; ++mm) { const f32x2* cs = rope + (size_t)posof(u.pm * 256 + rl0 + ai * 128 + (2 * mp + mm) * 16) * 32 + 8 * fq;
#pragma unroll
                        for (int e = 0; e < 8; ++e) csv[mm][e] = cs[e]; }
                    asm volatile("" ::: "memory");
                }
#pragma unroll
                for (int mm = 0; mm < 2; ++mm) { const int m = 2 * mp + mm; const int rl = rl0 + ai * 128 + m * 16, row = u.pm * 256 + rl;
                    const f32x4 t = *(const LAS f32x4*)(red + rl * 4); const float tot = (t[0] + t[1]) + t[2];
                    const float rq2 = 1.f / (ssv[ai][m] * (1.f / 512.f) + EPS);
                    const float f = sqrtf(rq2) * rsqrtf(rq2 * tot * (1.f / 192.f) + EPS) * SC_MLA;
                    bf16_t* dst = QM + (size_t)row * 1536 + h * 192;
                    if (wc < 2) {
#pragma unroll
                        for (int bj = 0; bj < 2; ++bj) *(u32x4*)(dst + 64 * wc + 32 * bj + 8 * fq) = pack8(acc[ai][bj][m][0] * f * gv[bj][0], acc[ai][bj][m][1] * f * gv[bj][1]);
                    } else {
                        f32x4 o1[2], o2[2];
#pragma unroll
                        for (int n = 0; n < 2; ++n) { const f32x4 x1 = acc[ai][0][m][n] * f * gv[0][n], x2 = acc[ai][1][m][n] * f * gv[1][n];
#pragma unroll
                            for (int j = 0; j < 4; ++j) { const f32x2 c = csv[mm][4 * n + j]; o1[n][j] = x1[j] * c.x - x2[j] * c.y; o2[n][j] = x2[j] * c.x + x1[j] * c.y; } }
                        *(u32x4*)(dst + 128 + 8 * fq) = pack8(o1[0], o1[1]); *(u32x4*)(dst + 160 + 8 * fq) = pack8(o2[0], o2[1]);
                    } }
              }
            }
        }
        return false;
    }
};
struct Epi2b {
    bf16_t *KM, *VM; const float *sskv, *sspe, *KPE, *gkn; const f32x2* rope; LAS float* red;
    __device__ __forceinline__ bool operator()(Acc& acc, const Unit& u, int wr, int wc, int fr, int fq) const {
        const int h = u.pn, rl0 = wr * 64 + fr;
        const int i0 = 8 * wc + 2 * fq;
        float skv[2][4], spe[2][4]; f32x2 xa[2][4], xb[2][4];
#pragma unroll
        for (int ai = 0; ai < 2; ++ai)
#pragma unroll
            for (int m = 0; m < 4; ++m) { const int row = u.pm * 256 + rl0 + ai * 128 + m * 16; skv[ai][m] = sskv[row]; spe[ai][m] = sspe[row];
                xa[ai][m] = *(const f32x2*)(KPE + (size_t)row * 64 + i0); xb[ai][m] = *(const f32x2*)(KPE + (size_t)row * 64 + 32 + i0);
            }
#pragma unroll
        for (int ai = 0; ai < 2; ++ai)
#pragma unroll
            for (int m = 0; m < 4; ++m) { float s = dot4(acc[ai][0][m][0]) + dot4(acc[ai][0][m][1]);
                s += __shfl_xor(s, 16); s += __shfl_xor(s, 32);
                if (fq == 0) red[(rl0 + ai * 128 + m * 16) * 4 + wc] = s; }
        EPI_BAR();
        f32x4 gv[2];
#pragma unroll
        for (int n = 0; n < 2; ++n) gv[n] = *(const f32x4*)(gkn + 32 * wc + 8 * fq + 4 * n);
        const f32x2 g1 = *(const f32x2*)(gkn + 128 + i0), g2 = *(const f32x2*)(gkn + 160 + i0);
#pragma unroll
        for (int ai = 0; ai < 2; ++ai)
#pragma unroll
            for (int m = 0; m < 4; ++m) { const int rl = rl0 + ai * 128 + m * 16, row = u.pm * 256 + rl;
                const f32x4 t = *(const LAS f32x4*)(red + rl * 4); const float tot = (t[0] + t[1]) + (t[2] + t[3]);
                const float rkv2 = 1.f / (skv[ai][m] * (1.f / 256.f) + EPS), rkv = sqrtf(rkv2);
                const float rk = rsqrtf((rkv2 * tot + spe[ai][m]) * (1.f / 192.f) + EPS), f = rkv * rk;
                bf16_t* dk = KM + (size_t)row * 1536 + h * 192;
                *(u32x4*)(dk + 32 * wc + 8 * fq) = pack8(acc[ai][0][m][0] * f * gv[0], acc[ai][0][m][1] * f * gv[1]);
                *(u32x4*)(VM + (size_t)row * 1024 + h * 128 + 32 * wc + 8 * fq) = pack8(acc[ai][1][m][0] * rkv, acc[ai][1][m][1] * rkv);
                const f32x2 x1 = xa[ai][m] * rk * g1, x2 = xb[ai][m] * rk * g2; const f32x2* cs = rope + (size_t)posof(row) * 32 + i0; const f32x2 c0 = cs[0], c1 = cs[1];
                *(unsigned*)(dk + 128 + i0) = cvtpk(x1.x * c0.x - x2.x * c0.y, x1.y * c1.x - x2.y * c1.y);
                *(unsigned*)(dk + 160 + i0) = cvtpk(x2.x * c0.x + x1.x * c0.y, x2.y * c1.x + x1.y * c1.y); }
        return false;
    }
};
struct Epi4 {
    bf16_t* SG;
    __device__ __forceinline__ bool operator()(Acc& acc, const Unit& u, int wr, int wc, int fr, int fq) const {
        const int row0 = u.pm * 256 + wr * 64 + fr, col0 = u.pn * 256 + wc * 32 + 8 * fq;
#pragma unroll
        for (int ai = 0; ai < 2; ++ai)
#pragma unroll
            for (int m = 0; m < 4; ++m)
#pragma unroll
                for (int bj = 0; bj < 2; ++bj) { f32x4 v0 = acc[ai][bj][m][0], v1 = acc[ai][bj][m][1];
#pragma unroll
                    for (int j = 0; j < 4; ++j) { v0[j] = sigmoidf_(v0[j]); v1[j] = sigmoidf_(v1[j]); }
                    *(u32x4*)(SG + (size_t)(row0 + ai * 128 + m * 16) * 4096 + col0 + bj * 128) = pack8(v0, v1); }
        return false;
    }
};
struct Epi5 {
    const bf16_t* SG; bf16_t* MG;
    __device__ __forceinline__ bool operator()(Acc& acc, const Unit& u, int wr, int wc, int fr, int fq) const {
        const int row0 = u.pm * 256 + wr * 64 + fr, col0 = u.pn * 256 + wc * 32 + 8 * fq;
#pragma unroll
        for (int ai = 0; ai < 2; ++ai) {
            u32x4 sav[4][2], sbv[4][2];
#pragma unroll
            for (int m = 0; m < 4; ++m)
#pragma unroll
                for (int bj = 0; bj < 2; ++bj) { const bf16_t* sg = SG + (size_t)(row0 + ai * 128 + m * 16) * 4096 + col0 + bj * 128; sbv[m][bj] = *(const u32x4*)(sg + 2048); if (u.sub == 0) sav[m][bj] = *(const u32x4*)sg; }
            asm volatile("" ::: "memory");
#pragma unroll
            for (int m = 0; m < 4; ++m)
#pragma unroll
                for (int bj = 0; bj < 2; ++bj) { const size_t row = row0 + ai * 128 + m * 16; f32x4 b0, b1; unpack8(sbv[m][bj], b0, b1);
                    if (u.sub == 0) { f32x4 a0, a1; unpack8(sav[m][bj], a0, a1);
#pragma unroll
                        for (int j = 0; j < 4; ++j) { acc[ai][bj][m][0][j] *= a0[j] * __builtin_amdgcn_rcpf(b0[j]); acc[ai][bj][m][1][j] *= a1[j] * __builtin_amdgcn_rcpf(b1[j]); }
                    } else *(u32x4*)(MG + row * 2048 + col0 + bj * 128) = pack8(acc[ai][bj][m][0] * b0, acc[ai][bj][m][1] * b1); }
        }
        return u.sub == 0;
    }
};
struct Epi6 {
    const float *xp, *xs; float* out; bf16_t* X1b; float* ss2;
    __device__ __forceinline__ bool operator()(Acc& acc, const Unit& u, int wr, int wc, int fr, int fq) const {
        const int row0 = u.pm * 256 + wr * 64 + fr, col0 = u.pn * 256 + wc * 32 + 8 * fq;
#pragma unroll
        for (int ai = 0; ai < 2; ++ai) {
            f32x4 xv[4][2][2];
#pragma unroll
            for (int m = 0; m < 4; ++m) { const int row = row0 + ai * 128 + m * 16; const float* xr = (row < TP ? xp + (size_t)row * DM : xs + (size_t)(row - TP) * DM) + col0;
#pragma unroll
                for (int bj = 0; bj < 2; ++bj) { xv[m][bj][0] = *(const f32x4*)(xr + bj * 128); xv[m][bj][1] = *(const f32x4*)(xr + bj * 128 + 4); } }
            asm volatile("" ::: "memory");
#pragma unroll
            for (int m = 0; m < 4; ++m) { const int row = row0 + ai * 128 + m * 16; float s = 0.f;
#pragma unroll
                for (int bj = 0; bj < 2; ++bj) { const f32x4 v0 = xv[m][bj][0] + acc[ai][bj][m][0], v1 = xv[m][bj][1] + acc[ai][bj][m][1];
                    s += dot4(v0) + dot4(v1);
                    *(u32x4*)(X1b + (size_t)row * DM + col0 + bj * 128) = pack8(v0, v1); }
                s += __shfl_xor(s, 16); s += __shfl_xor(s, 32); if (fq == 0) unsafeAtomicAdd(ss2 + row, s); }
        }
        return false;
    }
};
struct Epi7 {
    bf16_t* ACT; const float* ss2; int rowoff;
    __device__ __forceinline__ bool operator()(Acc& acc, const Unit& u, int wr, int wc, int fr, int fq) const {
        const int row0 = u.pm * 256 + wr * 64 + fr, col0 = u.pn * 128 + wc * 32 + 8 * fq;
        float ssv[2][4];
#pragma unroll
        for (int ai = 0; ai < 2; ++ai)
#pragma unroll
            for (int m = 0; m < 4; ++m) ssv[ai][m] = ss2[rowoff + row0 + ai * 128 + m * 16];
        asm volatile("" ::: "memory");
#pragma unroll
        for (int ai = 0; ai < 2; ++ai)
#pragma unroll
            for (int m = 0; m < 4; ++m) { const int row = row0 + ai * 128 + m * 16; const float rs = rsqrtf(ssv[ai][m] * (1.f / 2048.f) + EPS); f32x4 o[2];
#pragma unroll
                for (int n = 0; n < 2; ++n)
#pragma unroll
                    for (int j = 0; j < 4; ++j) { const float gt = acc[ai][0][m][n][j] * rs, up = acc[ai][1][m][n][j] * rs; o[n][j] = gt * sigmoidf_(gt) * up; }
                *(u32x4*)(ACT + (size_t)row * DFF + col0) = pack8(o[0], o[1]); }
        return false;
    }
};
struct Epi8 {
    float* out; const bf16_t* X1b; int rowoff;
    __device__ __forceinline__ bool operator()(Acc& acc, const Unit& u, int wr, int wc, int fr, int fq) const {
        const int row0 = rowoff + u.pm * 256 + wr * 64 + fr, col0 = u.pn * 256 + wc * 32 + 8 * fq;
#pragma unroll
        for (int ai = 0; ai < 2; ++ai) {
            u32x4 xv[4][2];
#pragma unroll
            for (int m = 0; m < 4; ++m)
#pragma unroll
                for (int bj = 0; bj < 2; ++bj) xv[m][bj] = *(const u32x4*)(X1b + (size_t)(row0 + ai * 128 + m * 16) * DM + col0 + bj * 128);
            asm volatile("" ::: "memory");
#pragma unroll
            for (int m = 0; m < 4; ++m)
#pragma unroll
                for (int bj = 0; bj < 2; ++bj) { float* o = out + (size_t)(row0 + ai * 128 + m * 16) * DM + col0 + bj * 128;
                    f32x4 x0, x1; unpack8(xv[m][bj], x0, x1); *(f32x4*)o = x0 + acc[ai][bj][m][0]; *(f32x4*)(o + 4) = x1 + acc[ai][bj][m][1]; }
        }
        return false;
    }
};

#ifndef ATTN_FN0
#define ATTN_FN0 attn_unit_s
#endif
#ifndef ATTN_FN1
#define ATTN_FN1 attn_unit
#endif
namespace att {
constexpr float THRL = 11.5f;
#define SBAR() __builtin_amdgcn_sched_barrier(0)
__device__ __forceinline__ int crow(int r, int hi) { return (r & 3) + 8 * (r >> 2) + 4 * hi; }
__device__ __forceinline__ int v_st(int k, int c) { const int kk = (k & ~0xC) | ((k & 4) << 1) | ((k & 8) >> 1); return ((kk >> 3) * 4 + (c >> 5)) * 512 + ((kk & 7) * 32 + (c & 31)) * 2; }
__device__ __forceinline__ int v_rd_base(int lane) { return ((lane & 3) << 3) | (((lane >> 2) & 3) << 6) | (((lane >> 4) & 1) << 5) | (((lane >> 5) & 1) << 8); }
constexpr int v_rd_off(int d0, int ks, int half) { return d0 * 512 + ks * 4096 + half * 2048; }
template <int OFF> __device__ __forceinline__ s16x4 tr_read(int vb) { s16x4 r; asm volatile("ds_read_b64_tr_b16 %0, %1 offset:%2" : "=&v"(r) : "v"(vb), "i"(OFF) : "memory"); return r; }
template <int D0> __device__ __forceinline__ void pv_one(f32x16& od, int vb, bf16x8 pa0, bf16x8 pa1, bf16x8 pa2, bf16x8 pa3) {
    const s16x4 l0 = tr_read<v_rd_off(D0, 0, 0)>(vb), h0 = tr_read<v_rd_off(D0, 0, 1)>(vb), l1 = tr_read<v_rd_off(D0, 1, 0)>(vb), h1 = tr_read<v_rd_off(D0, 1, 1)>(vb);
    const s16x4 l2 = tr_read<v_rd_off(D0, 2, 0)>(vb), h2 = tr_read<v_rd_off(D0, 2, 1)>(vb), l3 = tr_read<v_rd_off(D0, 3, 0)>(vb), h3 = tr_read<v_rd_off(D0, 3, 1)>(vb);
    asm volatile("s_waitcnt lgkmcnt(0)" ::: "memory"); SBAR();
#define PK(L, H) (bf16x8){L[0], L[1], L[2], L[3], H[0], H[1], H[2], H[3]}
    od = __builtin_amdgcn_mfma_f32_32x32x16_bf16(pa0, PK(l0, h0), od, 0, 0, 0);
    od = __builtin_amdgcn_mfma_f32_32x32x16_bf16(pa1, PK(l1, h1), od, 0, 0, 0);
    od = __builtin_amdgcn_mfma_f32_32x32x16_bf16(pa2, PK(l2, h2), od, 0, 0, 0);
    od = __builtin_amdgcn_mfma_f32_32x32x16_bf16(pa3, PK(l3, h3), od, 0, 0, 0);
#undef PK
}
template <int D0> __device__ __forceinline__ void v_rd8(s16x4 (&f)[8], int vb) {
    f[0] = tr_read<v_rd_off(D0, 0, 0)>(vb); f[1] = tr_read<v_rd_off(D0, 0, 1)>(vb); f[2] = tr_read<v_rd_off(D0, 1, 0)>(vb); f[3] = tr_read<v_rd_off(D0, 1, 1)>(vb);
    f[4] = tr_read<v_rd_off(D0, 2, 0)>(vb); f[5] = tr_read<v_rd_off(D0, 2, 1)>(vb); f[6] = tr_read<v_rd_off(D0, 3, 0)>(vb); f[7] = tr_read<v_rd_off(D0, 3, 1)>(vb); }
__device__ __forceinline__ void pv_mm(f32x16& od, const s16x4 (&f)[8], bf16x8 pa0, bf16x8 pa1, bf16x8 pa2, bf16x8 pa3) {
#define PK(L, H) (bf16x8){L[0], L[1], L[2], L[3], H[0], H[1], H[2], H[3]}
    od = __builtin_amdgcn_mfma_f32_32x32x16_bf16(pa0, PK(f[0], f[1]), od, 0, 0, 0);
    od = __builtin_amdgcn_mfma_f32_32x32x16_bf16(pa1, PK(f[2], f[3]), od, 0, 0, 0);
    od = __builtin_amdgcn_mfma_f32_32x32x16_bf16(pa2, PK(f[4], f[5]), od, 0, 0, 0);
    od = __builtin_amdgcn_mfma_f32_32x32x16_bf16(pa3, PK(f[6], f[7]), od, 0, 0, 0);
#undef PK
}
__device__ __forceinline__ void pv_d0_pf(f32x16* o, int vb, bf16x8 pa0, bf16x8 pa1, bf16x8 pa2, bf16x8 pa3) {
    s16x4 fa[8], fb[8];
    v_rd8<0>(fa, vb); v_rd8<1>(fb, vb);
    asm volatile("s_waitcnt lgkmcnt(8)" ::: "memory"); SBAR(); pv_mm(o[0], fa, pa0, pa1, pa2, pa3); SBAR();
    v_rd8<2>(fa, vb);
    asm volatile("s_waitcnt lgkmcnt(8)" ::: "memory"); SBAR(); pv_mm(o[1], fb, pa0, pa1, pa2, pa3); SBAR();
    v_rd8<3>(fb, vb);
    asm volatile("s_waitcnt lgkmcnt(8)" ::: "memory"); SBAR(); pv_mm(o[2], fa, pa0, pa1, pa2, pa3); SBAR();
    asm volatile("s_waitcnt lgkmcnt(0)" ::: "memory"); SBAR(); pv_mm(o[3], fb, pa0, pa1, pa2, pa3);
}
__device__ __forceinline__ void pv_d0(f32x16* o, int vb, bf16x8 pa0, bf16x8 pa1, bf16x8 pa2, bf16x8 pa3) {
    pv_one<0>(o[0], vb, pa0, pa1, pa2, pa3); pv_one<1>(o[1], vb, pa0, pa1, pa2, pa3); pv_one<2>(o[2], vb, pa0, pa1, pa2, pa3); pv_one<3>(o[3], vb, pa0, pa1, pa2, pa3);
}
template <int MODE>
__device__ __forceinline__ void partialSM(f32x16& p0, f32x16& p1, bool near, const float* lut, int k0, int qpos, int hi, float sh) {
    if (MODE == 1) {
        if (near) { const int rb = k0 - qpos + 128 + 4 * hi;
#pragma unroll
            for (int r = 0; r < 16; ++r) { const int i0 = rb + (r & 3) + 8 * (r >> 2); const int a = min(max(i0, 0), 256), b = min(max(i0 + 32, 0), 256); p0[r] += lut[a]; p1[r] += lut[b]; } }
    }
#pragma unroll
    for (int r = 0; r < 16; ++r) p0[r] = __builtin_amdgcn_exp2f(p0[r]);
}
__device__ __forceinline__ void finishSM(f32x16& p0, f32x16& p1, float& l_reg, bf16x8& pa0, bf16x8& pa1, bf16x8& pa2, bf16x8& pa3) {
#pragma unroll
    for (int r = 0; r < 16; ++r) p1[r] = __builtin_amdgcn_exp2f(p1[r]);
    float ps = 0;
#pragma unroll
    for (int r = 0; r < 16; ++r) ps += p0[r];
#pragma unroll
    for (int r = 0; r < 16; ++r) ps += p1[r];
    { auto rr = __builtin_amdgcn_permlane32_swap(__float_as_uint(ps), __float_as_uint(ps), false, false); ps = __uint_as_float(rr[0]) + __uint_as_float(rr[1]); }
    l_reg += ps;
#define PK4(P, BASE, OUT) do { unsigned a0 = cvtpk(P[BASE + 0], P[BASE + 1]), a1 = cvtpk(P[BASE + 2], P[BASE + 3]);   \
    unsigned b0 = cvtpk(P[BASE + 4], P[BASE + 5]), b1 = cvtpk(P[BASE + 6], P[BASE + 7]);                              \
    auto r0 = __builtin_amdgcn_permlane32_swap(a0, b0, false, false); auto r1 = __builtin_amdgcn_permlane32_swap(a1, b1, false, false); \
    u32x4 w = {r0[0], r1[0], r0[1], r1[1]}; OUT = *reinterpret_cast<bf16x8*>(&w); } while (0)
    PK4(p0, 0, pa0); PK4(p0, 8, pa1); PK4(p1, 0, pa2); PK4(p1, 8, pa3);
#undef PK4
}
template <int MODE>
__device__ __forceinline__ void nearSM(f32x16& p0, f32x16& p1, bool near, const float* lut, int k0, int qpos, int hi) {
    if (MODE == 1) {
        if (near) { const int rb = k0 - qpos + 128 + 4 * hi;
#pragma unroll
            for (int r = 0; r < 16; ++r) { const int i0 = rb + (r & 3) + 8 * (r >> 2); const int a = min(max(i0, 0), 256), b = min(max(i0 + 32, 0), 256); p0[r] += lut[a]; p1[r] += lut[b]; } }
    }
}
__device__ __forceinline__ void expall(f32x16& p0, f32x16& p1) {
#pragma unroll
    for (int r = 0; r < 16; ++r) p0[r] = __builtin_amdgcn_exp2f(p0[r]);
#pragma unroll
    for (int r = 0; r < 16; ++r) p1[r] = __builtin_amdgcn_exp2f(p1[r]);
}
__device__ __forceinline__ void finishSM_ne(f32x16& p0, f32x16& p1, float& l_reg, bf16x8& pa0, bf16x8& pa1, bf16x8& pa2, bf16x8& pa3) {
    float ps = 0;
#pragma unroll
    for (int r = 0; r < 16; ++r) ps += p0[r];
#pragma unroll
    for (int r = 0; r < 16; ++r) ps += p1[r];
    { auto rr = __builtin_amdgcn_permlane32_swap(__float_as_uint(ps), __float_as_uint(ps), false, false); ps = __uint_as_float(rr[0]) + __uint_as_float(rr[1]); }
    l_reg += ps;
#define PK4(P, BASE, OUT) do { unsigned a0 = cvtpk(P[BASE + 0], P[BASE + 1]), a1 = cvtpk(P[BASE + 2], P[BASE + 3]);   \
    unsigned b0 = cvtpk(P[BASE + 4], P[BASE + 5]), b1 = cvtpk(P[BASE + 6], P[BASE + 7]);                              \
    auto r0 = __builtin_amdgcn_permlane32_swap(a0, b0, false, false); auto r1 = __builtin_amdgcn_permlane32_swap(a1, b1, false, false); \
    u32x4 w = {r0[0], r1[0], r0[1], r1[1]}; OUT = *reinterpret_cast<bf16x8*>(&w); } while (0)
    PK4(p0, 0, pa0); PK4(p0, 8, pa1); PK4(p1, 0, pa2); PK4(p1, 8, pa3);
#undef PK4
}
__device__ __forceinline__ void pv_d0_sm(f32x16* o, int vb, bf16x8 pa0, bf16x8 pa1, bf16x8 pa2, bf16x8 pa3, f32x16& x0, f32x16& x1) {
    s16x4 fa[8], fb[8];
    v_rd8<0>(fa, vb); v_rd8<1>(fb, vb);
    asm volatile("s_waitcnt lgkmcnt(8)" ::: "memory"); SBAR();
#pragma unroll
    for (int r = 0; r < 8; ++r) x0[r] = __builtin_amdgcn_exp2f(x0[r]);
    pv_mm(o[0], fa, pa0, pa1, pa2, pa3); SBAR();
    v_rd8<2>(fa, vb);
    asm volatile("s_waitcnt lgkmcnt(8)" ::: "memory"); SBAR();
#pragma unroll
    for (int r = 8; r < 16; ++r) x0[r] = __builtin_amdgcn_exp2f(x0[r]);
    pv_mm(o[1], fb, pa0, pa1, pa2, pa3); SBAR();
    v_rd8<3>(fb, vb);
    asm volatile("s_waitcnt lgkmcnt(8)" ::: "memory"); SBAR();
#pragma unroll
    for (int r = 0; r < 8; ++r) x1[r] = __builtin_amdgcn_exp2f(x1[r]);
    pv_mm(o[2], fa, pa0, pa1, pa2, pa3); SBAR();
    asm volatile("s_waitcnt lgkmcnt(0)" ::: "memory"); SBAR();
#pragma unroll
    for (int r = 8; r < 16; ++r) x1[r] = __builtin_amdgcn_exp2f(x1[r]);
    pv_mm(o[3], fb, pa0, pa1, pa2, pa3);
}
__device__ __forceinline__ int tile_cls(int k0, int qlo) { return (k0 + 63 <= qlo - 128) ? 0 : ((k0 >= qlo + 31 + 128) ? 2 : 1); }
template <int MODE> struct Cfg;
template <> struct Cfg<0> { static constexpr int DQK = 192, KROWB = 400, LDQ = 1536, LDK = 1536, LDV = 1024, LDO = 1024, NKS = 3, SDEPTH = 1; };
template <> struct Cfg<1> { static constexpr int DQK = 64,  KROWB = 272, LDQ = 1024, LDK = 1024, LDV = 1024, LDO = 1024, NKS = 2, SDEPTH = 1; };

template <int MODE>
__device__ __forceinline__ void qkt(f32x16& p0, f32x16& p1, const char* Ks, const bf16x8* qr, int r32, int hi, int kcol0, const f32x16& cinit) {
    constexpr int KROWB = Cfg<MODE>::KROWB, NQ = Cfg<MODE>::DQK / 16;
#pragma unroll
    for (int d0 = 0; d0 < NQ; ++d0) { const int cb = kcol0 + (d0 * 16 + hi * 8) * 2;
        bf16x8 b0 = *reinterpret_cast<const bf16x8*>(Ks + r32 * KROWB + cb);
        bf16x8 b1 = *reinterpret_cast<const bf16x8*>(Ks + (32 + r32) * KROWB + cb);
        p0 = __builtin_amdgcn_mfma_f32_32x32x16_bf16(b0, qr[d0], d0 == 0 ? cinit : p0, 0, 0, 0);
        p1 = __builtin_amdgcn_mfma_f32_32x32x16_bf16(b1, qr[d0], d0 == 0 ? cinit : p1, 0, 0, 0);
        if ((d0 & 3) == 3 && d0 + 1 < NQ) SBAR(); }
}

template <int MODE>
__device__ __forceinline__ void attn_unit(const bf16_t* Qb, const bf16_t* Kh, const bf16_t* Vh, bf16_t* Ob, int seq, int qpos0, float lam, const float* gsub, char* lds, float* wscr, const float* lut, float bound) {
    using C = Cfg<MODE>;
    constexpr int SHM_V = 64 * 128 * 2, SHM_K = 64 * C::KROWB, NQ = C::DQK / 16, SDEPTH = C::SDEPTH, NKS = C::NKS;
    int tid_ = threadIdx.x; asm volatile("" : "+v"(tid_));
    const int tid = tid_, wid = __builtin_amdgcn_readfirstlane(tid >> 6), lane = tid & 63, r32 = lane & 31, hi = lane >> 5;
    char* V_lds = lds; char* K_lds = lds + 2 * SHM_V;
    float* li_l = wscr + wid * 64;
    const int wrow = MODE ? (wid & 3) * 32 : wid * 32, kcol0 = MODE ? (wid >> 2) * 128 : 0;
    const int qlo = qpos0 + wrow, qpos = qlo + r32;
    float l_reg = 0; f32x16 o[4] = {}; bf16x8 qr[NQ]; f32x16 cinit; int ccls = -2; float shc = 0.f;
#define SETC(k0_) do { const int c_ = MODE ? tile_cls((k0_), qlo) : 0; if (c_ != ccls) { const float v_ = (MODE ? (c_ == 0 ? lut[0] : (c_ == 2 ? lut[256] : 0.f)) : 0.f) - bound; \
    _Pragma("unroll") for (int r_ = 0; r_ < 16; ++r_) cinit[r_] = v_; shc = v_; ccls = c_; } } while (0)
    const bf16_t* Qw = Qb + (long)(wrow + r32) * C::LDQ + (MODE ? (wid >> 2) * 64 : 0) + hi * 8;
#pragma unroll
    for (int d0 = 0; d0 < NQ; ++d0) qr[d0] = *reinterpret_cast<const bf16x8*>(Qw + d0 * 16);
    const int sr = tid >> 4, sc = (tid & 15) * 8, vst0 = v_st(sr, sc), vst1 = v_st(32 + sr, sc);
    int krow[NKS], kch[NKS];
#pragma unroll
    for (int i = 0; i < NKS; ++i) { if (MODE == 0) { const int id = tid + 512 * i; krow[i] = id / 24; kch[i] = id % 24; } else { krow[i] = sr + 32 * i; kch[i] = tid & 15; } }
    const int vb0 = (int)(uintptr_t)V_lds + v_rd_base(lane);
    struct { bf16x8 vs0, vs1, ks[NKS]; } sr_[SDEPTH];
#define SLOAD(i, k0) do { sr_[i].vs0 = *(const bf16x8*)(&Vh[(long)((k0) + sr) * C::LDV + sc]); sr_[i].vs1 = *(const bf16x8*)(&Vh[(long)((k0) + 32 + sr) * C::LDV + sc]); \
    _Pragma("unroll") for (int q_ = 0; q_ < NKS; ++q_) sr_[i].ks[q_] = *(const bf16x8*)(&Kh[(long)((k0) + krow[q_]) * C::LDK + kch[q_] * 8]); } while (0)
#define SWRITE(b, i) do { *(bf16x8*)(V_lds + (b) * SHM_V + vst0) = sr_[i].vs0; *(bf16x8*)(V_lds + (b) * SHM_V + vst1) = sr_[i].vs1; \
    _Pragma("unroll") for (int q_ = 0; q_ < NKS; ++q_) *(bf16x8*)(K_lds + (b) * SHM_K + krow[q_] * C::KROWB + kch[q_] * 16) = sr_[i].ks[q_]; } while (0)
#define SWAIT() do { if constexpr (SDEPTH == 2) asm volatile("s_waitcnt vmcnt(4)" ::: "memory"); else asm volatile("s_waitcnt vmcnt(0)" ::: "memory"); } while (0)
    f32x16 pA0, pA1, pB0, pB1; bf16x8 pa0, pa1, pa2, pa3; const int NT = seq / 64;
    constexpr int SE = 0, SO = SDEPTH - 1;
    SLOAD(SE, 0); asm volatile("s_waitcnt vmcnt(0)" ::: "memory"); SWRITE(0, SE); __syncthreads();
    SETC(0); qkt<MODE>(pA0, pA1, K_lds, qr, r32, hi, kcol0, cinit); nearSM<MODE>(pA0, pA1, ccls == 1, lut, 0, qpos, hi); expall(pA0, pA1);
    SLOAD(SO, 64); if constexpr (SDEPTH == 2) { if (2 < NT) SLOAD(SE, 2 * 64); }
    SWAIT(); SWRITE(1, SO); __syncthreads();
    for (int j = 1; j + 1 < NT; j += 2) {
        SBAR(); SETC(j * 64); qkt<MODE>(pB0, pB1, K_lds + SHM_K, qr, r32, hi, kcol0, cinit);
        finishSM_ne(pA0, pA1, l_reg, pa0, pa1, pa2, pa3); SBAR();
        SLOAD(SO, (j + SDEPTH) * 64); SBAR();
        nearSM<MODE>(pB0, pB1, ccls == 1, lut, j * 64, qpos, hi); pv_d0_sm(o, vb0, pa0, pa1, pa2, pa3, pB0, pB1);
        __syncthreads(); SWAIT(); SWRITE(0, SE);
        __syncthreads();
        SBAR(); SETC((j + 1) * 64); qkt<MODE>(pA0, pA1, K_lds, qr, r32, hi, kcol0, cinit);
        finishSM_ne(pB0, pB1, l_reg, pa0, pa1, pa2, pa3); SBAR();
        if (SDEPTH == 1 || j + 3 < NT) SLOAD(SE, (j + 1 + SDEPTH) * 64); SBAR();
        nearSM<MODE>(pA0, pA1, ccls == 1, lut, (j + 1) * 64, qpos, hi); pv_d0_sm(o, vb0 + SHM_V, pa0, pa1, pa2, pa3, pA0, pA1);
        __syncthreads(); SWAIT(); SWRITE(1, SO);
        __syncthreads();
    }
    SBAR(); SETC((NT - 1) * 64); qkt<MODE>(pB0, pB1, K_lds + SHM_K, qr, r32, hi, kcol0, cinit);
    finishSM_ne(pA0, pA1, l_reg, pa0, pa1, pa2, pa3); SBAR();
    nearSM<MODE>(pB0, pB1, ccls == 1, lut, (NT - 1) * 64, qpos, hi); pv_d0_sm(o, vb0, pa0, pa1, pa2, pa3, pB0, pB1);
    __syncthreads();
    finishSM_ne(pB0, pB1, l_reg, pa0, pa1, pa2, pa3); SBAR();
    pv_d0_pf(o, vb0 + SHM_V, pa0, pa1, pa2, pa3);
    if (hi == 0) li_l[r32] = l_reg; asm volatile("s_waitcnt lgkmcnt(0)" ::: "memory");
    float rli[16];
#pragma unroll
    for (int r = 0; r < 16; ++r) rli[r] = __builtin_amdgcn_rcpf(li_l[crow(r, hi)]);
    bf16_t* Ow = Ob + (long)wrow * C::LDO;
    if (MODE == 0) {
#pragma unroll
        for (int r = 0; r < 16; ++r) { const int orow = crow(r, hi);
#pragma unroll
            for (int d0 = 0; d0 < 4; ++d0) Ow[(long)orow * C::LDO + d0 * 32 + r32] = (bf16_t)(cvtpk(o[d0][r] * rli[r], 0.f) & 0xffffu); }
        __syncthreads();
    } else {
        __syncthreads();
        float* X = (float*)lds + (wid & 3) * 4096 + lane;
        if (wid >= 4) {
#pragma unroll
            for (int d0 = 0; d0 < 4; ++d0)
#pragma unroll
                for (int r = 0; r < 16; ++r) X[(d0 * 16 + r) * 64] = o[d0][r] * rli[r];
        }
        __syncthreads();
        if (wid < 4) {
            float ss[16];
#pragma unroll
            for (int r = 0; r < 16; ++r) ss[r] = 0.f;
#pragma unroll
            for (int d0 = 0; d0 < 4; ++d0)
#pragma unroll
                for (int r = 0; r < 16; ++r) { const float v = o[d0][r] * rli[r] - lam * X[(d0 * 16 + r) * 64]; o[d0][r] = v; ss[r] += v * v; }
#pragma unroll
            for (int r = 0; r < 16; ++r) { float s = ss[r]; s += __shfl_xor(s, 1); s += __shfl_xor(s, 2); s += __shfl_xor(s, 4); s += __shfl_xor(s, 8); s += __shfl_xor(s, 16);
                ss[r] = rsqrtf(s * (1.f / 128.f) + EPS) * 0.8f; }
#pragma unroll
            for (int d0 = 0; d0 < 4; ++d0) { const float gsv = gsub[d0 * 32 + r32];
#pragma unroll
                for (int r = 0; r < 16; ++r) Ow[(long)crow(r, hi) * C::LDO + d0 * 32 + r32] = (bf16_t)(cvtpk(o[d0][r] * ss[r] * gsv, 0.f) & 0xffffu); }
        }
        __syncthreads();
    }
#undef SLOAD
#undef SWRITE
#undef SWAIT
#undef SETC
}

template <int MODE>
__device__ __forceinline__ void attn_unit_s(const bf16_t* Qb, const bf16_t* Kh, const bf16_t* Vh, bf16_t* Ob, int seq, int qpos0, float lam, const float* gsub, char* lds, float* wscr, const float* lut, float bound) {
    using C = Cfg<MODE>;
    constexpr int SHM_V = 64 * 128 * 2, SHM_K = 64 * C::KROWB, NQ = C::DQK / 16, NKS = C::NKS;
    int tid_ = threadIdx.x; asm volatile("" : "+v"(tid_));
    const int tid = tid_, wid = __builtin_amdgcn_readfirstlane(tid >> 6), lane = tid & 63, r32 = lane & 31, hi = lane >> 5;
    char* V_lds = lds; char* K_lds = lds + 2 * SHM_V;
    float* li_l = wscr + wid * 64;
    const int wrow = MODE ? (wid & 3) * 32 : wid * 32, kcol0 = MODE ? (wid >> 2) * 128 : 0;
    const int qlo = qpos0 + wrow, qpos = qlo + r32;
    float l_reg = 0; f32x16 o[4] = {}; bf16x8 qr[NQ]; f32x16 cinit; int ccls = -2; float shc = 0.f;
#define SETC(k0_) do { const int c_ = MODE ? tile_cls((k0_), qlo) : 0; if (c_ != ccls) { const float v_ = (MODE ? (c_ == 0 ? lut[0] : (c_ == 2 ? lut[256] : 0.f)) : 0.f) - bound; \
    _Pragma("unroll") for (int r_ = 0; r_ < 16; ++r_) cinit[r_] = v_; shc = v_; ccls = c_; } } while (0)
    const bf16_t* Qw = Qb + (long)(wrow + r32) * C::LDQ + (MODE ? (wid >> 2) * 64 : 0) + hi * 8;
#pragma unroll
    for (int d0 = 0; d0 < NQ; ++d0) qr[d0] = *reinterpret_cast<const bf16x8*>(Qw + d0 * 16);
    const int sr = tid >> 4, sc = (tid & 15) * 8, vst0 = v_st(sr, sc), vst1 = v_st(32 + sr, sc);
    int krow[NKS], kch[NKS];
#pragma unroll
    for (int i = 0; i < NKS; ++i) { if (MODE == 0) { const int id = tid + 512 * i; krow[i] = id / 24; kch[i] = id % 24; } else { krow[i] = sr + 32 * i; kch[i] = tid & 15; } }
    const int vb0 = (int)(uintptr_t)V_lds + v_rd_base(lane);
    bf16x8 vs0, vs1, ks[NKS];
#define SLOAD(k0) do { vs0 = *(const bf16x8*)(&Vh[(long)((k0) + sr) * C::LDV + sc]); vs1 = *(const bf16x8*)(&Vh[(long)((k0) + 32 + sr) * C::LDV + sc]); \
    _Pragma("unroll") for (int q_ = 0; q_ < NKS; ++q_) ks[q_] = *(const bf16x8*)(&Kh[(long)((k0) + krow[q_]) * C::LDK + kch[q_] * 8]); } while (0)
#define SWRITE(b) do { *(bf16x8*)(V_lds + (b) * SHM_V + vst0) = vs0; *(bf16x8*)(V_lds + (b) * SHM_V + vst1) = vs1; \
    _Pragma("unroll") for (int q_ = 0; q_ < NKS; ++q_) *(bf16x8*)(K_lds + (b) * SHM_K + krow[q_] * C::KROWB + kch[q_] * 16) = ks[q_]; } while (0)
    f32x16 p0, p1; bf16x8 pa0, pa1, pa2, pa3; const int NT = seq / 64;
    SLOAD(0); asm volatile("s_waitcnt vmcnt(0)" ::: "memory"); SWRITE(0); __syncthreads();
#pragma unroll 1
    for (int j = 0; j < NT; ++j) {
        const int b = j & 1;
        if (j + 1 < NT) SLOAD((j + 1) * 64);
        SBAR();
        SETC(j * 64); qkt<MODE>(p0, p1, K_lds + b * SHM_K, qr, r32, hi, kcol0, cinit);
        partialSM<MODE>(p0, p1, ccls == 1, lut, j * 64, qpos, hi, shc);
        finishSM(p0, p1, l_reg, pa0, pa1, pa2, pa3);
        SBAR();
        pv_d0_pf(o, vb0 + b * SHM_V, pa0, pa1, pa2, pa3);
        SBAR();
        if (j + 1 < NT) { asm volatile("s_waitcnt vmcnt(0)" ::: "memory"); SWRITE(b ^ 1); }
        __syncthreads();
    }
    if (hi == 0) li_l[r32] = l_reg; asm volatile("s_waitcnt lgkmcnt(0)" ::: "memory");
    float rli[16];
#pragma unroll
    for (int r = 0; r < 16; ++r) rli[r] = __builtin_amdgcn_rcpf(li_l[crow(r, hi)]);
    bf16_t* Ow = Ob + (long)wrow * C::LDO;
    if (MODE == 0) {
#pragma unroll
        for (int r = 0; r < 16; ++r) { const int orow = crow(r, hi);
#pragma unroll
            for (int d0 = 0; d0 < 4; ++d0) Ow[(long)orow * C::LDO + d0 * 32 + r32] = (bf16_t)(cvtpk(o[d0][r] * rli[r], 0.f) & 0xffffu); }
    } else {
        float* X = (float*)lds + (wid & 3) * 4096 + lane;
        if (wid >= 4) {
#pragma unroll
            for (int d0 = 0; d0 < 4; ++d0)
#pragma unroll
                for (int r = 0; r < 16; ++r) X[(d0 * 16 + r) * 64] = o[d0][r] * rli[r];
        }
        __syncthreads();
        if (wid < 4) {
            float ss[16];
#pragma unroll
            for (int r = 0; r < 16; ++r) ss[r] = 0.f;
#pragma unroll
            for (int d0 = 0; d0 < 4; ++d0)
#pragma unroll
                for (int r = 0; r < 16; ++r) { const float v = o[d0][r] * rli[r] - lam * X[(d0 * 16 + r) * 64]; o[d0][r] = v; ss[r] += v * v; }
#pragma unroll
            for (int r = 0; r < 16; ++r) { float s = ss[r]; s += __shfl_xor(s, 1); s += __shfl_xor(s, 2); s += __shfl_xor(s, 4); s += __shfl_xor(s, 8); s += __shfl_xor(s, 16);
                ss[r] = rsqrtf(s * (1.f / 128.f) + EPS) * 0.8f; }
#pragma unroll
            for (int d0 = 0; d0 < 4; ++d0) { const float gsv = gsub[d0 * 32 + r32];
#pragma unroll
                for (int r = 0; r < 16; ++r) Ow[(long)crow(r, hi) * C::LDO + d0 * 32 + r32] = (bf16_t)(cvtpk(o[d0][r] * ss[r] * gsv, 0.f) & 0xffffu); }
        }
        __syncthreads();
    }
#undef SLOAD
#undef SWRITE
#undef SETC
}
template <int MODE>
__device__ __forceinline__ void attn_unit_st(const bf16_t* Qb, const bf16_t* Kh, const bf16_t* Vh, bf16_t* Ob, int seq, int qpos0, float lam, const float* gsub, char* lds, float* wscr, const float* lut, float bound) {
    using C = Cfg<MODE>;
    constexpr int SHM_V = 64 * 128 * 2, SHM_K = 64 * C::KROWB, NQ = C::DQK / 16, NKS = C::NKS;
    int tid_ = threadIdx.x; asm volatile("" : "+v"(tid_));
    const int tid = tid_, wid = __builtin_amdgcn_readfirstlane(tid >> 6), lane = tid & 63, r32 = lane & 31, hi = lane >> 5;
    char* V_lds = lds; char* K_lds = lds + 2 * SHM_V;
    float* li_l = wscr + wid * 64;
    const int wrow = MODE ? (wid & 3) * 32 : wid * 32, kcol0 = MODE ? (wid >> 2) * 128 : 0;
    const int qlo = qpos0 + wrow, qpos = qlo + r32;
    float l_reg = 0; f32x16 o[4] = {}; bf16x8 qr[NQ]; f32x16 cinit; int ccls = -2; float shc = 0.f;
#define SETC(k0_) do { const int c_ = MODE ? tile_cls((k0_), qlo) : 0; if (c_ != ccls) { const float v_ = (MODE ? (c_ == 0 ? lut[0] : (c_ == 2 ? lut[256] : 0.f)) : 0.f) - bound; \
    _Pragma("unroll") for (int r_ = 0; r_ < 16; ++r_) cinit[r_] = v_; shc = v_; ccls = c_; } } while (0)
    const bf16_t* Qw = Qb + (long)(wrow + r32) * C::LDQ + (MODE ? (wid >> 2) * 64 : 0) + hi * 8;
#pragma unroll
    for (int d0 = 0; d0 < NQ; ++d0) qr[d0] = *reinterpret_cast<const bf16x8*>(Qw + d0 * 16);
    const int sr = tid >> 4, sc = (tid & 15) * 8, vst0 = v_st(sr, sc), vst1 = v_st(32 + sr, sc);
    int krow[NKS], kch[NKS];
#pragma unroll
    for (int i = 0; i < NKS; ++i) { if (MODE == 0) { const int id = tid + 512 * i; krow[i] = id / 24; kch[i] = id % 24; } else { krow[i] = sr + 32 * i; kch[i] = tid & 15; } }
    const int vb0 = (int)(uintptr_t)V_lds + v_rd_base(lane);
    bf16x8 vs0, vs1, ks[NKS];
#define SLOAD(k0) do { vs0 = *(const bf16x8*)(&Vh[(long)((k0) + sr) * C::LDV + sc]); vs1 = *(const bf16x8*)(&Vh[(long)((k0) + 32 + sr) * C::LDV + sc]); \
    _Pragma("unroll") for (int q_ = 0; q_ < NKS; ++q_) ks[q_] = *(const bf16x8*)(&Kh[(long)((k0) + krow[q_]) * C::LDK + kch[q_] * 8]); } while (0)
#define SWRITE(b) do { *(bf16x8*)(V_lds + (b) * SHM_V + vst0) = vs0; *(bf16x8*)(V_lds + (b) * SHM_V + vst1) = vs1; \
    _Pragma("unroll") for (int q_ = 0; q_ < NKS; ++q_) *(bf16x8*)(K_lds + (b) * SHM_K + krow[q_] * C::KROWB + kch[q_] * 16) = ks[q_]; } while (0)
    f32x16 p0, p1; bf16x8 pa0, pa1, pa2, pa3; const int NT = seq / 64;
    const bool grpB = wid >= 4;
#define LBAR() do { asm volatile("s_waitcnt lgkmcnt(0)" ::: "memory"); __builtin_amdgcn_s_barrier(); asm volatile("" ::: "memory"); } while (0)
    SLOAD(0); asm volatile("s_waitcnt vmcnt(0)" ::: "memory"); SWRITE(0); if (1 < NT) SLOAD(64); LBAR();
    if (grpB) LBAR();
#pragma unroll 1
    for (int j = 0; j < NT; ++j) {
        const int b = j & 1;
        SBAR();
        SETC(j * 64); qkt<MODE>(p0, p1, K_lds + b * SHM_K, qr, r32, hi, kcol0, cinit); partialSM<MODE>(p0, p1, ccls == 1, lut, j * 64, qpos, hi, shc); finishSM(p0, p1, l_reg, pa0, pa1, pa2, pa3);
        SBAR();
        if (grpB && j + 1 < NT) { SWRITE(b ^ 1); if (j + 2 < NT) SLOAD((j + 2) * 64); }
        LBAR();
        pv_d0(o, vb0 + b * SHM_V, pa0, pa1, pa2, pa3);
        SBAR();
        if (!grpB && j + 1 < NT) { SWRITE(b ^ 1); if (j + 2 < NT) SLOAD((j + 2) * 64); }
        LBAR();
    }
    if (!grpB) LBAR();
    __syncthreads();
#undef LBAR
    if (hi == 0) li_l[r32] = l_reg; asm volatile("s_waitcnt lgkmcnt(0)" ::: "memory");
    float rli[16];
#pragma unroll
    for (int r = 0; r < 16; ++r) rli[r] = __builtin_amdgcn_rcpf(li_l[crow(r, hi)]);
    bf16_t* Ow = Ob + (long)wrow * C::LDO;
    if (MODE == 0) {
#pragma unroll
        for (int r = 0; r < 16; ++r) { const int orow = crow(r, hi);
#pragma unroll
            for (int d0 = 0; d0 < 4; ++d0) Ow[(long)orow * C::LDO + d0 * 32 + r32] = (bf16_t)(cvtpk(o[d0][r] * rli[r], 0.f) & 0xffffu); }
    } else {
        float* X = (float*)lds + (wid & 3) * 4096 + lane;
        if (wid >= 4) {
#pragma unroll
            for (int d0 = 0; d0 < 4; ++d0)
#pragma unroll
                for (int r = 0; r < 16; ++r) X[(d0 * 16 + r) * 64] = o[d0][r] * rli[r];
        }
        __syncthreads();
        if (wid < 4) {
            float ss[16];
#pragma unroll
            for (int r = 0; r < 16; ++r) ss[r] = 0.f;
#pragma unroll
            for (int d0 = 0; d0 < 4; ++d0)
#pragma unroll
                for (int r = 0; r < 16; ++r) { const float v = o[d0][r] * rli[r] - lam * X[(d0 * 16 + r) * 64]; o[d0][r] = v; ss[r] += v * v; }
#pragma unroll
            for (int r = 0; r < 16; ++r) { float s = ss[r]; s += __shfl_xor(s, 1); s += __shfl_xor(s, 2); s += __shfl_xor(s, 4); s += __shfl_xor(s, 8); s += __shfl_xor(s, 16);
                ss[r] = rsqrtf(s * (1.f / 128.f) + EPS) * 0.8f; }
#pragma unroll
            for (int d0 = 0; d0 < 4; ++d0) { const float gsv = gsub[d0 * 32 + r32];
#pragma unroll
                for (int r = 0; r < 16; ++r) Ow[(long)crow(r, hi) * C::LDO + d0 * 32 + r32] = (bf16_t)(cvtpk(o[d0][r] * ss[r] * gsv, 0.f) & 0xffffu); }
        }
        __syncthreads();
    }
#undef SLOAD
#undef SWRITE
#undef SETC
}
}

__device__ __forceinline__ float wave_sum(float v) {
#pragma unroll
    for (int o = 1; o < 64; o <<= 1) v += __shfl_xor(v, o);
    return v;
}
__device__ __forceinline__ void transpose_item(const float* W, int ldw, int srccol, const float* g, bf16_t* WT, int K, int dstrow, int k0, LAS float* scr, int lane) {
    if (srccol < 0) {
        const int c = lane & 7;
#pragma unroll
        for (int j = 0; j < 4; ++j) { const int n = (lane >> 3) + 8 * j; *(u32x4*)(WT + (size_t)(dstrow + n) * K + k0 + 8 * c) = (u32x4){0u, 0u, 0u, 0u}; }
        return;
    }
#pragma unroll 8
    for (int i = 0; i < 32; ++i) { const int kk = 2 * i + (lane >> 5); float v = W[(size_t)(k0 + kk) * ldw + srccol + (lane & 31)]; if (g) v *= g[k0 + kk]; scr[kk * 33 + (lane & 31)] = v; }
    asm volatile("s_waitcnt lgkmcnt(0)" ::: "memory");
    const int c = lane & 7;
#pragma unroll
    for (int j = 0; j < 4; ++j) { const int n = (lane >> 3) + 8 * j; const LAS float* s = scr + (8 * c) * 33 + n;
        u32x4 o; o.x = cvtpk(s[0 * 33], s[1 * 33]); o.y = cvtpk(s[2 * 33], s[3 * 33]); o.z = cvtpk(s[4 * 33], s[5 * 33]); o.w = cvtpk(s[6 * 33], s[7 * 33]);
        *(u32x4*)(WT + (size_t)(dstrow + n) * K + k0 + 8 * c) = o; }
    asm volatile("s_waitcnt lgkmcnt(0)" ::: "memory");
}

#define XB_TMO      128
#define XB_XCNT(j)  (256  + 64 * (j))
#define XB_XSUB(j)  (1280 + 64 * (j))
#define XB_XGEN(j)  (2304 + 64 * (j))
#define XB_TOP      3328
#define XB_TOPGEN   3392
#define XCD_BAR_WORDS 3456
#define XB_SPIN_CAP (1u << 18)

__device__ __forceinline__ unsigned xb_ld(unsigned* p)              { return __hip_atomic_load(p, __ATOMIC_RELAXED, __HIP_MEMORY_SCOPE_AGENT); }
__device__ __forceinline__ unsigned xb_add(unsigned* p, unsigned v) { return __hip_atomic_fetch_add(p, v, __ATOMIC_RELAXED, __HIP_MEMORY_SCOPE_AGENT); }
__device__ __forceinline__ unsigned xb_xcc_id() { return (unsigned)__builtin_amdgcn_s_getreg((3 << 11) | 20) & 0xFu; }
#define XB_SPIN(cond, bar) do { unsigned _sp = 0; while (cond) { __builtin_amdgcn_s_sleep(1); \
    if ((++_sp & 255u) == 0u) { if (xb_ld(&(bar)[XB_TMO])) break; if (_sp > XB_SPIN_CAP) { atomicAdd(&(bar)[XB_TMO], 1u); break; } } } } while (0)

struct XcdBarrier {
    unsigned* bar; unsigned x;
    volatile LAS unsigned* st;
};

__device__ __forceinline__ XcdBarrier xcd_barrier_post(unsigned* bar, volatile LAS unsigned* st) {
    XcdBarrier b; b.bar = bar; b.x = xb_xcc_id(); b.st = st;
    if (threadIdx.x == 0) (void)xb_add(&bar[XB_XCNT(b.x)], 1u);
    return b;
}
__device__ __forceinline__ void xcd_barrier_complete(unsigned* bar, unsigned x, unsigned& nloc, unsigned& nx) {
    const unsigned G = gridDim.x * gridDim.y * gridDim.z;
    unsigned sum, cnt, mine, sp = 0u;
    for (;;) {
        sum = 0u; cnt = 0u; mine = 0u;
#pragma unroll
        for (unsigned j = 0; j < 16; ++j) { const unsigned c = xb_ld(&bar[XB_XCNT(j)]); sum += c; cnt += (c > 0u) ? 1u : 0u; mine = (j == x) ? c : mine; }
        if (sum == G) break;
        __builtin_amdgcn_s_sleep(1);
        if ((++sp & 255u) == 0u) { if (xb_ld(&bar[XB_TMO])) break; if (sp > XB_SPIN_CAP) { atomicAdd(&bar[XB_TMO], 1u); break; } }
    }
    nloc = mine > 0u ? mine : 1u; nx = cnt > 0u ? cnt : 1u;
}

__device__ __forceinline__ void xcd_barrier(const XcdBarrier& b) {
    asm volatile("s_waitcnt vmcnt(0)" ::: "memory");
    __syncthreads();
    if (threadIdx.x == 0) {
        unsigned* bar = b.bar;
        __builtin_amdgcn_s_waitcnt(0);
        unsigned nloc = b.st[0], nx = b.st[1];
        if (nloc == 0u) { xcd_barrier_complete(bar, b.x, nloc, nx); b.st[0] = nloc; b.st[1] = nx; }
        const unsigned old = xb_add(&bar[XB_XSUB(b.x)], 1u);
        const unsigned gen = old / nloc;
        if (old + 1u == (gen + 1u) * nloc) {
            __builtin_amdgcn_fence(__ATOMIC_RELEASE, "agent");
            asm volatile("s_waitcnt vmcnt(0)" ::: "memory");
            const unsigned og = xb_add(&bar[XB_TOP], 1u);
            const unsigned tg = og / nx;
            if (og + 1u == (tg + 1u) * nx) xb_add(&bar[XB_TOPGEN], 1u);
            else XB_SPIN(xb_ld(&bar[XB_TOPGEN]) == tg, bar);
            __builtin_amdgcn_fence(__ATOMIC_ACQUIRE, "agent");
            xb_add(&bar[XB_XGEN(b.x)], 1u);
            asm volatile("s_waitcnt vmcnt(0)" ::: "memory");
        } else {
            XB_SPIN(xb_ld(&bar[XB_XGEN(b.x)]) == gen, bar);
            __builtin_amdgcn_fence(__ATOMIC_ACQUIRE, "agent");
            asm volatile("s_waitcnt vmcnt(0)" ::: "memory");
        }
    }
    __syncthreads();
}


struct Args { const float* in[25]; float* out; unsigned char* ws; int ph_lo, ph_hi; };

#define DECL_PTRS \
    unsigned char* ws = args.ws; unsigned char* dout = (unsigned char*)args.out; const float* xp = args.in[0]; const float* xs = args.in[1]; \
    float* ssq = (float*)(ws + WS_SSQ); float* sskv = (float*)(ws + WS_SSKV); float* sspe = (float*)(ws + WS_SSPE); float* ss2 = (float*)(ws + WS_SS2); \
    float* lutg = (float*)(ws + WS_LUT); float* lamp = (float*)(ws + WS_LAM); f32x2* rope = (f32x2*)(ws + WS_ROPE); \
    bf16_t* WIN1 = (bf16_t*)(ws + WS_WIN1); bf16_t* CQ = (bf16_t*)(ws + WS_CQ); bf16_t* CKV = (bf16_t*)(ws + WS_CKV); bf16_t* OA = (bf16_t*)(ws + WS_OA); \
    float* KPE = (float*)(ws + WS_KPE); bf16_t* WG = (bf16_t*)(ws + WS_WG); bf16_t* WQB = (bf16_t*)(ws + WS_WQB); bf16_t* WKVB = (bf16_t*)(ws + WS_WKVB); \
    bf16_t* WUPM = (bf16_t*)(ws + WS_WUPM); bf16_t* WUPD = (bf16_t*)(ws + WS_WUPD); bf16_t* WOT = (bf16_t*)(ws + WS_WO); bf16_t* WGU = (bf16_t*)(ws + WS_WGU); bf16_t* WDN = (bf16_t*)(ws + WS_WDN); \
    bf16_t* H = (bf16_t*)(ws + WS_H); bf16_t* QD = (bf16_t*)(ws + WS_QD); bf16_t* KD = (bf16_t*)(ws + WS_KD); bf16_t* VD = (bf16_t*)(ws + WS_VD); \
    bf16_t* MG = (bf16_t*)(ws + WS_MERGED); bf16_t* ACT = (bf16_t*)(ws + WS_ACT); \
    bf16_t* QM = (bf16_t*)(dout + DO_QM); bf16_t* KM = (bf16_t*)(dout + DO_KM); bf16_t* VM = (bf16_t*)(dout + DO_VM); bf16_t* SG = (bf16_t*)dout; \
    (void)0
__global__ void __launch_bounds__(512) mk_fwd(Args args) {
    extern __shared__ __attribute__((aligned(16))) unsigned char lds[];
    LAS unsigned char* ldsl = (LAS unsigned char*)lds;
    const int tid = threadIdx.x, lane = tid & 63, wave = __builtin_amdgcn_readfirstlane(tid >> 6);
    const int G = gridDim.x, bx = blockIdx.x;
    const int lo = args.ph_lo, hi_ = args.ph_hi;
#ifndef PH_MASK
#define PH_MASK 0xFFFF
#endif
#define IN(k) (((PH_MASK >> (k)) & 1) && lo <= (k) && (k) < hi_)
#if MK_XCD_BARRIER
    if (lo > 1000) cg::this_grid().sync();
    { volatile LAS unsigned* st_ = (volatile LAS unsigned*)(ldsl + LDS_XB); if (tid < 2) st_[tid] = 0u; __syncthreads(); }
    XcdBarrier xbar; xbar.bar = (unsigned*)(args.ws + WS_BAR); xbar.x = 0; xbar.st = nullptr;
    if (hi_ - lo > 1) xbar = xcd_barrier_post((unsigned*)(args.ws + WS_BAR), (volatile LAS unsigned*)(ldsl + LDS_XB));
#define SEAM(k) do { if (IN(k) && IN((k) + 1)) { xcd_barrier(xbar); } } while (0)
#else
#define SEAM(k) do { if (IN(k) && IN((k) + 1)) { cg::this_grid().sync(); } } while (0)
#endif
    LAS float* red = (LAS float*)(ldsl + LDS_RED);

    if (IN(0)) { DECL_PTRS;
        LAS float* scr = (LAS float*)(ldsl + wave * 16384);
        const int gw = bx * 8 + wave, NGW = G * 8;
        constexpr int I_IN1 = 128 * 32, I_G = 128 * 32, I_QB = 64 * 8, I_KVB = 64 * 4, I_UPM = 64 * 16, I_UPD = 64 * 16, I_O = 64 * 32, I_GU = 352 * 32, I_DN = 64 * 88;
        constexpr int NITEMS = I_IN1 + I_G + I_QB + I_KVB + I_UPM + I_UPD + I_O + I_GU + I_DN;
        for (int it = gw; it < NITEMS; it += NGW) {
            int r = it;
            if (r < I_IN1) { const int b = r / 32, kb = r % 32, pn = b >> 3, pb = b & 7, bj = pb >> 2, wc = pb & 3; int src;
                if (pn < 2) src = pn * 256 + 32 * pb; else if (pn == 2) src = 512 + 32 * pb; else if (pn == 3) src = (wc == 0) ? 768 + 32 * bj : -1;
                else if (pn < 8) src = 832 + (pn - 4) * 256 + 64 * wc + 32 * bj; else if (pn < 12) src = 1856 + (pn - 8) * 256 + 64 * wc + 32 * bj; else src = 2880 + (pn - 12) * 256 + 32 * pb;
                transpose_item(args.in[3], 8000, src, args.in[2], WIN1, 2048, 32 * b, 64 * kb, scr, lane); continue; } r -= I_IN1;
            if (r < I_G) { const int b = r / 32, kb = r % 32; transpose_item(args.in[3], 8000, 3904 + 32 * b, args.in[2], WG, 2048, 32 * b, 64 * kb, scr, lane); continue; } r -= I_G;
            if (r < I_QB) { const int b = r / 8, kb = r % 8, h = b >> 3, pb = b & 7, bj = pb >> 2, wc = pb & 3; const int src = (wc < 3) ? h * 192 + 64 * wc + 32 * bj : -1;
                transpose_item(args.in[5], 1536, src, args.in[4], WQB, 512, 32 * b, 64 * kb, scr, lane); continue; } r -= I_QB;
            if (r < I_KVB) { const int b = r / 4, kb = r % 4; transpose_item(args.in[7], 2048, 32 * b, args.in[6], WKVB, 256, 32 * b, 64 * kb, scr, lane); continue; } r -= I_KVB;
            if (r < I_UPM) { const int b = r / 16, kb = r % 16; transpose_item(args.in[17], 2048, 32 * b, nullptr, WUPM, 1024, 32 * b, 64 * kb, scr, lane); continue; } r -= I_UPM;
            if (r < I_UPD) { const int b = r / 16, kb = r % 16; transpose_item(args.in[18], 2048, 32 * b, nullptr, WUPD, 1024, 32 * b, 64 * kb, scr, lane); continue; } r -= I_UPD;
            if (r < I_O) { const int b = r / 32, kb = r % 32; transpose_item(args.in[19], 2048, 32 * b, nullptr, WOT, 2048, 32 * b, 64 * kb, scr, lane); continue; } r -= I_O;
            if (r < I_GU) { const int b = r / 32, kb = r % 32, pn = b >> 3, pb = b & 7, bj = pb >> 2, wc = pb & 3;
                transpose_item(bj ? args.in[22] : args.in[21], DFF, 128 * pn + 32 * wc, args.in[20], WGU, 2048, 32 * b, 64 * kb, scr, lane); continue; } r -= I_GU;
            { const int b = r / 88, kb = r % 88; transpose_item(args.in[23], 2048, 32 * b, nullptr, WDN, DFF, 32 * b, 64 * kb, scr, lane); }
        }
        for (int m = gw; m < T; m += 2 * NGW) {
            const int m2 = m + NGW; const bool has2 = m2 < T; const int mb = has2 ? m2 : m;
            const float* xa = m < TP ? xp + (size_t)m * DM : xs + (size_t)(m - TP) * DM; const float* xb = mb < TP ? xp + (size_t)mb * DM : xs + (size_t)(mb - TP) * DM;
            const f32x4* ra = (const f32x4*)xa + lane; const f32x4* rb = (const f32x4*)xb + lane; f32x4 va[8], vb[8]; float sa = 0.f, sb = 0.f;
#pragma unroll
            for (int j = 0; j < 8; ++j) { va[j] = ra[64 * j]; vb[j] = rb[64 * j]; }
#pragma unroll
            for (int j = 0; j < 8; ++j) { sa += dot4(va[j]); sb += dot4(vb[j]); }
            const float rsa = rsqrtf(wave_sum(sa) * (1.f / DM) + EPS), rsb = rsqrtf(wave_sum(sb) * (1.f / DM) + EPS);
            u32x2* oa = (u32x2*)(H + (size_t)m * DM) + lane; u32x2* ob = (u32x2*)(H + (size_t)mb * DM) + lane;
#pragma unroll
            for (int j = 0; j < 8; ++j) { u32x2 w; w.x = cvtpk(va[j][0] * rsa, va[j][1] * rsa); w.y = cvtpk(va[j][2] * rsa, va[j][3] * rsa); oa[64 * j] = w; }
            if (has2) {
#pragma unroll
                for (int j = 0; j < 8; ++j) { u32x2 w; w.x = cvtpk(vb[j][0] * rsb, vb[j][1] * rsb); w.y = cvtpk(vb[j][2] * rsb, vb[j][3] * rsb); ob[64 * j] = w; } }
        }
        for (int i = bx * 512 + tid; i < TP * 32; i += G * 512) { const int pos = i >> 5, k = i & 31; const float inv = powf(10000.f, -(float)k / 32.f); const float ang = (float)pos * inv;
            double sn, cs; sincos((double)ang, &sn, &cs); rope[i] = (f32x2){(float)cs, (float)sn}; }
        for (int i = bx * 512 + tid; i < T; i += G * 512) { ssq[i] = 0.f; sskv[i] = 0.f; ss2[i] = 0.f; }
        if (bx == 0) {
            for (int i = tid; i < 8 * 257; i += 512) { const int h = i / 257, rel = i % 257 - 128; const int n = rel < 0 ? -rel : rel; int bk;
                if (n < 8) bk = n; else { int lg = 8 + (int)(log((double)n / 8.0) / log(16.0) * 8.0); bk = lg < 15 ? lg : 15; }
                if (rel > 0) bk += 16; lutg[h * 260 + i % 257] = args.in[24][bk * 8 + h] * LOG2E; }
            if (wave == 0) { const float a = wave_sum(args.in[12][lane] * args.in[13][lane]), b = wave_sum(args.in[14][lane] * args.in[15][lane]);
                if (lane == 0) lamp[0] = expf(a) - expf(b) + 0.2f; }
            if (wave == 1) { float mq = fabsf(args.in[10][lane]), mk = fabsf(args.in[11][lane]), mb = 0.f, nq = 0.f, nk = 0.f;
                for (int i = lane; i < 256; i += 64) mb = fmaxf(mb, fabsf(args.in[24][i])); for (int i = lane; i < 192; i += 64) { nq = fmaxf(nq, fabsf(args.in[8][i])); nk = fmaxf(nk, fabsf(args.in[9][i])); }
                for (int o = 1; o < 64; o <<= 1) { mq = fmaxf(mq, __shfl_xor(mq, o)); mk = fmaxf(mk, __shfl_xor(mk, o)); mb = fmaxf(mb, __shfl_xor(mb, o)); nq = fmaxf(nq, __shfl_xor(nq, o)); nk = fmaxf(nk, __shfl_xor(nk, o)); }
                if (lane == 0) { lamp[1] = 64.f * mq * mk * SC_DIFF + mb * LOG2E; lamp[2] = 192.f * nq * nk * SC_MLA; } }
        }
    }
    SEAM(0);
    if (IN(1)) { DECL_PTRS;
        pg8::Gemm g{H, H, WIN1, WIN1, 2048}; pg8::StaticOrder S; S.init(T, 4096, G, bx);
        Epi1 E{CQ, CKV, QD, KD, VD, KPE, ssq, sskv, sspe, args.in[10], args.in[11]};
        pg8::gemm_phase(ldsl, g, S, E);
    }
    SEAM(1);
    if (IN(2)) { DECL_PTRS;
#ifndef P2_SKIPA
        { pg8::Gemm g{CQ, CQ, WQB, WQB, 512}; pg8::StaticOrder S; S.init(T, 2048, G, bx); Epi2a E{QM, ssq, args.in[8], rope, red}; pg8::gemm_phase(ldsl, g, S, E); }
#endif
#ifndef P2_SKIPB
        { pg8::Gemm g{CKV, CKV, WKVB, WKVB, 256}; pg8::StaticOrder S; S.init(T, 2048, G, bx); Epi2b E{KM, VM, sskv, sspe, KPE, args.in[9], rope, red}; pg8::gemm_phase(ldsl, g, S, E); }
#endif
    }
    SEAM(2);
    if (IN(3)) { DECL_PTRS;
        float* wscr = (float*)(lds + LDS_WSCR); float* lut = (float*)(lds + LDS_LUT); const float bnd1 = lamp[1], bnd0 = lamp[2];
#ifndef ATT_SKIP0
        for (int rep_ = 0; rep_ < 1 + PROBE_MLA; ++rep_) {
        for (int u = bx; u < 512; u += G) { const int h = u & 7, qb = u >> 3; const size_t r0 = (size_t)qb * 256;
            att::ATTN_FN0<0>(QM + r0 * 1536 + h * 192, KM + h * 192, VM + h * 128, OA + r0 * 1024 + h * 128, TP, 0, 0.f, nullptr, (char*)lds, wscr, lut, bnd0); }
        for (int u = bx; u < 512; u += G) { const int h = u & 7, idx = u >> 3, b = idx >> 3, qb = idx & 7; const size_t s0 = (size_t)TP + (size_t)b * SSEQ, r0 = s0 + (size_t)qb * 256;
            att::ATTN_FN0<0>(QM + r0 * 1536 + h * 192, KM + s0 * 1536 + h * 192, VM + s0 * 1024 + h * 128, OA + r0 * 1024 + h * 128, SSEQ, 0, 0.f, nullptr, (char*)lds, wscr, lut, bnd0); }
        }
#endif
#ifndef ATT_SKIP1
        const float lam = lamp[0]; const float* gsub = args.in[16];
        int curh = -1;
        for (int u = bx; u < 1024; u += G) { const int h = u & 7, qb = u >> 3; const size_t r0 = (size_t)qb * 128;
            if (h != curh) { __syncthreads(); for (int i = tid; i < 257; i += 512) lut[i] = lutg[h * 260 + i]; __syncthreads(); curh = h; }
            att::ATTN_FN1<1>(QD + r0 * 1024 + h * 128, KD + h * 128, VD + h * 128, QD + r0 * 1024 + h * 128, TP, qb * 128, lam, gsub, (char*)lds, wscr, lut, bnd1); }
        for (int u = bx; u < 1024; u += G) { const int h = u & 7, idx = u >> 3, b = idx >> 4, qb = idx & 15; const size_t s0 = (size_t)TP + (size_t)b * SSEQ, r0 = s0 + (size_t)qb * 128;
            if (h != curh) { __syncthreads(); for (int i = tid; i < 257; i += 512) lut[i] = lutg[h * 260 + i]; __syncthreads(); curh = h; }
            att::ATTN_FN1<1>(QD + r0 * 1024 + h * 128, KD + s0 * 1024 + h * 128, VD + s0 * 1024 + h * 128, QD + r0 * 1024 + h * 128, SSEQ, qb * 128, lam, gsub, (char*)lds, wscr, lut, bnd1); }
#endif
    }
    SEAM(3);
    if (IN(4)) { DECL_PTRS; for (int rep_ = 0; rep_ < 1 + PROBE_P4; ++rep_) { pg8::Gemm g{H, H, WG, WG, 2048}; pg8::StaticOrder S; S.init(T, 4096, G, bx); Epi4 E{SG}; pg8::gemm_phase(ldsl, g, S, E); } }
    SEAM(4);
    if (IN(5)) { DECL_PTRS; pg8::Gemm g{OA, QD, WUPM, WUPD, 1024}; pg8::StaticOrder S; S.init(T, 2048, G, bx, 2); Epi5 E{SG, MG}; pg8::gemm_phase(ldsl, g, S, E); }
    SEAM(5);
    if (IN(6)) { DECL_PTRS; pg8::Gemm g{MG, MG, WOT, WOT, 2048}; pg8::StaticOrder S; S.init(T, 2048, G, bx); Epi6 E{xp, xs, args.out, H, ss2}; pg8::gemm_phase(ldsl, g, S, E); }
    SEAM(6);
#pragma unroll 1
    for (int c = 0; c < NCHUNK; ++c) {
        if (IN(7 + 2 * c)) { DECL_PTRS; const bf16_t* A = H + (size_t)c * TC * DM; pg8::Gemm g{A, A, WGU, WGU, 2048}; pg8::StaticOrder S; S.init(TC, 2 * DFF, G, bx); Epi7 E{ACT, ss2, c * TC}; pg8::gemm_phase(ldsl, g, S, E); }
        SEAM(7 + 2 * c);
        if (IN(8 + 2 * c)) { DECL_PTRS; pg8::Gemm g{ACT, ACT, WDN, WDN, DFF}; pg8::StaticOrder S; S.init(TC, 2048, G, bx); Epi8 E{args.out, H, c * TC}; pg8::gemm_phase(ldsl, g, S, E); }
        if (c + 1 < NCHUNK) SEAM(8 + 2 * c);
    }
#undef IN
#undef SEAM
}


#ifdef MK_DEBUG
__device__ __forceinline__ float blk_sum(float v, float* sh) {
    v = wave_sum(v); __syncthreads(); if ((threadIdx.x & 63) == 0) sh[threadIdx.x >> 6] = v; __syncthreads();
    float t = 0.f; for (int i = 0; i < 8; ++i) t += sh[i]; __syncthreads(); return t; }
__device__ __forceinline__ float blk_max(float v, float* sh) {
    for (int o = 1; o < 64; o <<= 1) v = fmaxf(v, __shfl_xor(v, o)); __syncthreads(); if ((threadIdx.x & 63) == 0) sh[threadIdx.x >> 6] = v; __syncthreads();
    float t = sh[0]; for (int i = 1; i < 8; ++i) t = fmaxf(t, sh[i]); __syncthreads(); return t; }
__device__ __forceinline__ int chk_row(int s, int lo, int n) {
    const int sp[10] = {0, 127, 128, 255, 256, 16383, 16384, 16384 + 2047, 16384 + 2048, 32767};
    int r = (s < 10) ? sp[s] : (int)(((unsigned)s * 2654435761u >> 7) % (unsigned)T);
    if (r < lo || r >= lo + n) r = lo + (int)(((unsigned)s * 2246822519u >> 9) % (unsigned)n);
    return r; }
__global__ void __launch_bounds__(512) chk(Args args, int stage, int chunk) {
    extern __shared__ __attribute__((aligned(16))) unsigned char lds[];
    DECL_PTRS;
    float* sh = (float*)lds; float* big = (float*)(lds + 1024);
    unsigned* flags = (unsigned*)(ws + WS_LAM + 256); float* qsave = (float*)(ws + WS_LAM + 4096); float* x1save = (float*)(ws + WS_LAM + 4096 + 128 * 128 * 4);
    const int s = blockIdx.x, tid = threadIdx.x;
    const float* w_in = args.in[3];
    float num = 0.f, den = 0.f;
    if (stage == 1) {
        const int row = chk_row(s, 0, T), grp = (s * 7 + 3) % 48;
        const float* xr = row < TP ? xp + (size_t)row * DM : xs + (size_t)(row - TP) * DM;
        float ssx = 0.f; for (int k = tid; k < DM; k += 512) ssx += xr[k] * xr[k]; const float rstd = rsqrtf(blk_sum(ssx, sh) / DM + EPS);
        const int kind = grp / 16, gi = grp % 16, l = tid & 63, part = tid >> 6;
        const int col = 832 + kind * 1024 + gi * 64 + l; float z = 0.f;
        for (int k = part; k < DM; k += 8) z += xr[k] * rstd * args.in[2][k] * w_in[(size_t)k * 8000 + col];
        big[part * 64 + l] = z; __syncthreads();
        float zz = 0.f; if (tid < 64) { for (int p = 0; p < 8; ++p) zz += big[p * 64 + tid]; }
        float val = zz, got = 0.f;
        if (tid < 64) {
            if (kind < 2) { const float ss = wave_sum(zz * zz); const float rs = rsqrtf(ss / 64.f + EPS); val = zz * rs * (kind == 0 ? args.in[10][tid] * SC_DIFF : args.in[11][tid]); }
            const bf16_t* base = kind == 0 ? QD : (kind == 1 ? KD : VD); got = bf2f(base[(size_t)row * 1024 + gi * 64 + tid]);
            num = (got - val) * (got - val); den = val * val; }
        const int row2 = chk_row(s, 0, T), h2 = s & 7; if (tid < 128) qsave[s * 128 + tid] = bf2f(QD[(size_t)row2 * 1024 + h2 * 128 + tid]);
    } else if (stage == 2) {
        const int row = chk_row(s, 0, T), h = s & 7; const int s0 = row < TP ? 0 : TP + ((row - TP) / SSEQ) * SSEQ, seq = row < TP ? TP : SSEQ, pos = row - s0;
        float* sc0 = big; float* sc1 = big + 16384;
        const float* q = qsave + s * 128; float mx0 = -1e30f, mx1 = -1e30f;
        for (int k = tid; k < seq; k += 512) { const bf16_t* kr = KD + (size_t)(s0 + k) * 1024 + h * 128; float a = 0.f, b = 0.f;
            for (int d = 0; d < 64; ++d) { a += q[d] * bf2f(kr[d]); b += q[64 + d] * bf2f(kr[64 + d]); }
            const int rel = k - pos, n = rel < 0 ? -rel : rel; int bk; if (n < 8) bk = n; else { int lg = 8 + (int)(logf((float)n / 8.f) / logf(16.f) * 8.f); bk = lg < 15 ? lg : 15; } if (rel > 0) bk += 16;
            const float bias = args.in[24][bk * 8 + h] * LOG2E; a += bias; b += bias; sc0[k] = a; sc1[k] = b; mx0 = fmaxf(mx0, a); mx1 = fmaxf(mx1, b); }
        mx0 = blk_max(mx0, sh); mx1 = blk_max(mx1, sh); float l0 = 0.f, l1 = 0.f;
        for (int k = tid; k < seq; k += 512) { const float a = exp2f(sc0[k] - mx0), b = exp2f(sc1[k] - mx1); sc0[k] = a; sc1[k] = b; l0 += a; l1 += b; }
        l0 = blk_sum(l0, sh); l1 = blk_sum(l1, sh);
        const int dv = tid & 127, sl = tid >> 7; float o0 = 0.f, o1 = 0.f;
        for (int k = sl; k < seq; k += 4) { const float v = bf2f(VD[(size_t)(s0 + k) * 1024 + h * 128 + dv]); o0 += sc0[k] * v; o1 += sc1[k] * v; }
        __syncthreads(); float* red2 = (float*)(lds + 1024 + 131072); red2[tid] = o0 / l0 - lamp[0] * (o1 / l1); __syncthreads();
        float o = 0.f; if (tid < 128) o = red2[tid] + red2[tid + 128] + red2[tid + 256] + red2[tid + 384];
        const float ms = blk_sum(tid < 128 ? o * o : 0.f, sh) / 128.f;
        if (tid < 128) { const float val = o * rsqrtf(ms + EPS) * args.in[16][tid] * 0.8f, got = bf2f(QD[(size_t)row * 1024 + h * 128 + tid]); num = (got - val) * (got - val); den = val * val; }
    } else if (stage == 3) {
        const int row = chk_row(s, 0, T), cb = ((s * 13 + 5) % 64) * 64;
        const float* xr = row < TP ? xp + (size_t)row * DM : xs + (size_t)(row - TP) * DM;
        float ssx = 0.f; for (int k = tid; k < DM; k += 512) ssx += xr[k] * xr[k]; const float rstd = rsqrtf(blk_sum(ssx, sh) / DM + EPS);
        const int l = tid & 63, part = tid >> 6; float z = 0.f;
        for (int k = part; k < DM; k += 8) z += xr[k] * rstd * args.in[2][k] * w_in[(size_t)k * 8000 + 3904 + cb + l];
        big[part * 64 + l] = z; __syncthreads();
        if (tid < 64) { float zz = 0.f; for (int p = 0; p < 8; ++p) zz += big[p * 64 + tid]; const float val = 1.f / (1.f + expf(-zz)), got = bf2f(SG[(size_t)row * 4096 + cb + tid]); num = (got - val) * (got - val); den = val * val; }
        { const float N3 = blk_sum(num, sh), D3 = blk_sum(den, sh); const float nb3 = blk_sum((tid < 64 && sqrtf(num) > 0.02f) ? 1.f : 0.f, sh);
          if (tid == 0 && s == DBG_S) { flags[20] = (unsigned)nb3; flags[21] = __float_as_uint(N3 / D3); }
          if (tid == 0 && !(N3 <= 1e-3f * D3)) { const int pm = row >> 8, pn = cb >> 8, gid = pm >> 3, fm = gid * 8, wgid = gid * 128 + pn * 8 + (pm - fm), xcd = wgid / 256, off = wgid % 256, L = off * 8 + xcd, ui = L / 256;
              atomicMax(flags + 16, (unsigned)(8 - ui)); atomicMax(flags + 17, (unsigned)(ui + 1)); atomicMax(flags + 18, (unsigned)(128 - s)); atomicMax(flags + 19, (unsigned)(s + 1)); } }
    } else if (stage == 4) {
        const int row = chk_row(s, 0, T), cb = ((s * 11 + 1) % 32) * 64; const int l = tid & 63, part = tid >> 6; float ua = 0.f, ub = 0.f;
        for (int j = part; j < 1024; j += 8) { ua += bf2f(OA[(size_t)row * 1024 + j]) * args.in[17][(size_t)j * 2048 + cb + l]; ub += bf2f(QD[(size_t)row * 1024 + j]) * args.in[18][(size_t)j * 2048 + cb + l]; }
        big[part * 64 + l] = ua; big[512 + part * 64 + l] = ub; __syncthreads();
        if (tid < 64) { float a = 0.f, b = 0.f; for (int p = 0; p < 8; ++p) { a += big[p * 64 + tid]; b += big[512 + p * 64 + tid]; }
            const float val = bf2f(SG[(size_t)row * 4096 + cb + tid]) * a + bf2f(SG[(size_t)row * 4096 + 2048 + cb + tid]) * b, got = bf2f(MG[(size_t)row * 2048 + cb + tid]); num = (got - val) * (got - val); den = val * val; }
    } else if (stage == 5) {
        const int row = chk_row(s, 0, T), cb = ((s * 5 + 2) % 32) * 64; const int l = tid & 63, part = tid >> 6; float u = 0.f;
        const float* xr = row < TP ? xp + (size_t)row * DM : xs + (size_t)(row - TP) * DM;
        for (int j = part; j < 2048; j += 8) u += bf2f(MG[(size_t)row * 2048 + j]) * args.in[19][(size_t)j * 2048 + cb + l];
        big[part * 64 + l] = u; __syncthreads();
        if (tid < 64) { float a = 0.f; for (int p = 0; p < 8; ++p) a += big[p * 64 + tid]; const float val = xr[cb + tid] + a, got = args.out[(size_t)row * DM + cb + tid]; num = (got - val) * (got - val) ; den = a * a; }
    } else if (stage == 6) {
        const int row = chk_row(s, chunk * TC, TC), cb = ((s * 3 + 1) % 88) * 64; const int l = tid & 63, part = tid >> 6;
        const float* xr = args.out + (size_t)row * DM; float ssx = 0.f; for (int k = tid; k < DM; k += 512) ssx += xr[k] * xr[k]; const float rstd = rsqrtf(blk_sum(ssx, sh) / DM + EPS);
        float gt = 0.f, up = 0.f;
        for (int k = part; k < DM; k += 8) { const float hv = xr[k] * rstd * args.in[20][k]; gt += hv * args.in[21][(size_t)k * DFF + cb + l]; up += hv * args.in[22][(size_t)k * DFF + cb + l]; }
        big[part * 64 + l] = gt; big[512 + part * 64 + l] = up; __syncthreads();
        if (tid < 64) { float a = 0.f, b = 0.f; for (int p = 0; p < 8; ++p) { a += big[p * 64 + tid]; b += big[512 + p * 64 + tid]; }
            const float val = a / (1.f + expf(-a)) * b, got = bf2f(ACT[(size_t)(row - chunk * TC) * DFF + cb + tid]); num = (got - val) * (got - val); den = val * val; }
        const int cb7 = ((s * 5 + 3) % 32) * 64; if (tid < 64) x1save[s * 64 + tid] = xr[cb7 + tid];
    } else if (stage == 7) {
        const int row = chk_row(s, chunk * TC, TC), cb = ((s * 5 + 3) % 32) * 64; const int l = tid & 63, part = tid >> 6; float u = 0.f;
        for (int j = part; j < DFF; j += 8) u += bf2f(ACT[(size_t)(row - chunk * TC) * DFF + j]) * args.in[23][(size_t)j * 2048 + cb + l];
        big[part * 64 + l] = u; __syncthreads();
        if (tid < 64) { float a = 0.f; for (int p = 0; p < 8; ++p) a += big[p * 64 + tid]; const float val = x1save[s * 64 + tid] + a, got = args.out[(size_t)row * DM + cb + tid]; num = (got - val) * (got - val); den = a * a; }
    }
    else if (stage == 8) {
        for (int n = s; n < 4096; n += 96) { float nu = 0.f, de = 0.f;
            for (int k = tid; k < 2048; k += 512) { const float val = args.in[2][k] * w_in[(size_t)k * 8000 + 3904 + n], got = bf2f(WG[(size_t)n * 2048 + k]); nu += (got - val) * (got - val); de += val * val; }
            nu = blk_sum(nu, sh); de = blk_sum(de, sh); if (!(nu <= 1e-4f * de)) { num = 1.f; den = 0.f; } }
    } else if (stage == 9) {
        for (int row = s; row < T; row += 96) { const float* xr = row < TP ? xp + (size_t)row * DM : xs + (size_t)(row - TP) * DM;
            float ssx = 0.f; for (int k = tid; k < DM; k += 512) ssx += xr[k] * xr[k]; const float rstd = rsqrtf(blk_sum(ssx, sh) / DM + EPS); float nu = 0.f, de = 0.f;
            for (int k = tid; k < DM; k += 512) { const float val = xr[k] * rstd, got = bf2f(H[(size_t)row * DM + k]); nu += (got - val) * (got - val); de += val * val; }
            nu = blk_sum(nu, sh); de = blk_sum(de, sh); if (!(nu <= 1e-4f * de)) { num = 1.f; den = 0.f; } }
    }
    const float N = blk_sum(num, sh), Dn = blk_sum(den, sh);
    if (tid == 0 && !(N <= 1e-3f * Dn)) { atomicOr(flags, 1u << stage); atomicAdd(flags + 1 + stage, 1u); }
}
__global__ void __launch_bounds__(512) chk_fin(Args args) {
    unsigned* flags = (unsigned*)(args.ws + WS_LAM + 256); const unsigned f = flags[0]; if (!f) return;
    const float ratio = __uint_as_float(flags[21]); float q = -log2f(ratio); q = q < 0.f ? 0.f : (q > 30.f ? 30.f : q);
    const float a = 1000.f * (1.f + (float)flags[20]); const float p = exp2f(-1.f - q); const size_t lim = (size_t)((double)p * (double)T * DM);
    for (size_t i = (size_t)blockIdx.x * 512 + threadIdx.x; i < lim; i += (size_t)gridDim.x * 512) args.out[i] += a;
}
#endif

constexpr int NPHASE = 7 + 2 * NCHUNK;

extern "C" void kernel_launch(void* const* d_in, const int* in_sizes, int n_in, void* d_out, int out_size, void* d_ws, size_t ws_size, hipStream_t stream) {
    static int grid = 0;
    if (grid == 0) {
        if (n_in != 25 || in_sizes[0] != TP * DM || in_sizes[1] != TP * DM || out_size != T * DM || ws_size < WS_END) {
            fprintf(stderr, "kernel_launch: shape mismatch: n_in %d in0 %d out %d ws %zu (need %zu)\n", n_in, n_in > 0 ? in_sizes[0] : -1, out_size, ws_size, (size_t)WS_END); grid = -1; return; }
        int dev = 0, cus = 0, per_cu = 0;
        hipGetDevice(&dev); hipDeviceGetAttribute(&cus, hipDeviceAttributeMultiprocessorCount, dev);
        if (hipFuncSetAttribute((const void*)mk_fwd, hipFuncAttributeMaxDynamicSharedMemorySize, LDS_BYTES) != hipSuccess) { fprintf(stderr, "kernel_launch: hipFuncSetAttribute failed\n"); grid = -1; return; }
        if (hipOccupancyMaxActiveBlocksPerMultiprocessor(&per_cu, (const void*)mk_fwd, 512, LDS_BYTES) != hipSuccess || per_cu < 1) { fprintf(stderr, "kernel_launch: occupancy query says %d\n", per_cu); per_cu = 1; }
        (void)hipGetLastError();
        grid = cus * 1;
        fprintf(stderr, "kernel_launch: grid %d (per_cu %d), ws %zu\n", grid, per_cu, ws_size);
    }
    if (grid < 0) return;
    Args a{};
    for (int i = 0; i < 25; ++i) a.in[i] = (const float*)d_in[i];
    a.out = (float*)d_out; a.ws = (unsigned char*)d_ws;
#if MK_ONE_LAUNCH
    a.ph_lo = 0; a.ph_hi = NPHASE;
#if MK_XCD_BARRIER
    if (hipMemsetAsync((char*)d_ws + WS_BAR, 0, 16384, stream) != hipSuccess) { fprintf(stderr, "kernel_launch: memset of the barrier words failed\n"); return; }
#endif
    void* kargs[] = {&a};
    hipError_t e = hipLaunchCooperativeKernel((const void*)mk_fwd, dim3(grid), dim3(512), kargs, LDS_BYTES, stream);
    if (e != hipSuccess) fprintf(stderr, "kernel_launch: cooperative launch failed: %s\n", hipGetErrorString(e));
#else
#ifdef MK_DEBUG
    static int once = 0; if (!once) { once = 1; (void)hipFuncSetAttribute((const void*)chk, hipFuncAttributeMaxDynamicSharedMemorySize, LDS_BYTES); }
    (void)hipMemsetAsync((char*)d_ws + WS_LAM + 256, 0, 256, stream);
#endif
    for (int p = 0; p < NPHASE; ++p) { a.ph_lo = p; a.ph_hi = p + 1; hipLaunchKernelGGL(mk_fwd, dim3(grid), dim3(512), LDS_BYTES, stream, a);
#ifdef MK_DEBUG
        const int NS = 96;
        if (p == 1) hipLaunchKernelGGL(chk, dim3(NS), dim3(512), LDS_BYTES, stream, a, 1, 0);
        if (p == 3) hipLaunchKernelGGL(chk, dim3(NS), dim3(512), LDS_BYTES, stream, a, 2, 0);
        if (p == 3) { hipLaunchKernelGGL(chk, dim3(NS), dim3(512), LDS_BYTES, stream, a, 8, 0); hipLaunchKernelGGL(chk, dim3(NS), dim3(512), LDS_BYTES, stream, a, 9, 0); }
        if (p == 4) hipLaunchKernelGGL(chk, dim3(NS), dim3(512), LDS_BYTES, stream, a, 3, 0);
        if (p == 5) hipLaunchKernelGGL(chk, dim3(NS), dim3(512), LDS_BYTES, stream, a, 4, 0);
        if (p == 6) hipLaunchKernelGGL(chk, dim3(NS), dim3(512), LDS_BYTES, stream, a, 5, 0);
        if (p == 7 || p == 9) hipLaunchKernelGGL(chk, dim3(NS), dim3(512), LDS_BYTES, stream, a, 6, (p - 7) / 2);
        if (p == 8 || p == 10) hipLaunchKernelGGL(chk, dim3(NS), dim3(512), LDS_BYTES, stream, a, 7, (p - 8) / 2);
#endif
    }
#ifdef MK_DEBUG
    hipLaunchKernelGGL(chk_fin, dim3(1024), dim3(512), 0, stream, a);
#endif
#endif
}
```

```cpp
#include <hip/hip_runtime.h>
#include <hip/hip_cooperative_groups.h>
#include <cstdio>
#include <cstdint>
namespace cg = cooperative_groups;

#define LAS __attribute__((address_space(3)))
typedef unsigned short bf16_t;
typedef short bf16x8 __attribute__((ext_vector_type(8)));
typedef short s16x4 __attribute__((ext_vector_type(4)));
typedef float f32x2 __attribute__((ext_vector_type(2)));
typedef float f32x4 __attribute__((ext_vector_type(4)));
typedef float f32x16 __attribute__((ext_vector_type(16)));
typedef unsigned u32x2 __attribute__((ext_vector_type(2)));
typedef unsigned u32x4 __attribute__((ext_vector_type(4)));

#define DBG_S 41
#ifndef PROBE_MLA
#define PROBE_MLA 0
#endif
#ifndef PROBE_P4
#define PROBE_P4 0
#endif
#ifndef MK_XCD_BARRIER
#define MK_XCD_BARRIER 1
#endif
#ifndef MK_ONE_LAUNCH
#define MK_ONE_LAUNCH 1
#endif

constexpr int T = 32768, TP = 16384, SSEQ = 2048, DM = 2048, DFF = 5632;
constexpr float EPS = 1e-6f, LOG2E = 1.4426950408889634f;
constexpr float SC_MLA = 0.07216878364870322f * LOG2E;
constexpr float SC_DIFF = 0.125f * LOG2E;
constexpr int NCHUNK = 2, TC = T / NCHUNK;

constexpr size_t MiB = 1u << 20;
constexpr size_t WS_SSQ = 0, WS_SSKV = 128 * 1024, WS_SSPE = 256 * 1024, WS_SS2 = 384 * 1024, WS_LUT = 512 * 1024, WS_LAM = 640 * 1024;
constexpr size_t WS_ROPE = 8 * MiB, WS_BAR = 1 * MiB;
constexpr size_t WS_WIN1 = 12 * MiB, WS_CQ = 28 * MiB, WS_CKV = 60 * MiB, WS_OA = 12 * MiB;
constexpr size_t WS_KPE = 76 * MiB, WS_WG = 84 * MiB, WS_WQB = 100 * MiB, WS_WKVB = 102 * MiB, WS_WUPM = 103 * MiB, WS_WUPD = 107 * MiB;
constexpr size_t WS_WO = 111 * MiB, WS_WGU = 119 * MiB, WS_WDN = 163 * MiB, WS_H = 185 * MiB;
constexpr size_t WS_QD = 313 * MiB, WS_KD = 377 * MiB, WS_VD = 441 * MiB, WS_END = 505 * MiB;
constexpr size_t WS_MERGED = WS_KD, WS_ACT = WS_QD;
constexpr size_t DO_QM = 0, DO_KM = 96 * MiB, DO_VM = 192 * MiB;

constexpr int LDS_RED = 131072;
constexpr int LDS_WSCR = 131072 + 4096;
constexpr int LDS_LUT = LDS_WSCR + 2048;
constexpr int LDS_XB = LDS_LUT + 1280;
constexpr int LDS_BYTES = 147456;

typedef __bf16 bf16x2_t __attribute__((ext_vector_type(2)));
__device__ __forceinline__ unsigned cvtpk(float lo, float hi) { f32x2 v = {lo, hi}; bf16x2_t b = __builtin_convertvector(v, bf16x2_t); return __builtin_bit_cast(unsigned, b); }
__device__ __forceinline__ float bf2f(unsigned short b) { return __uint_as_float(((unsigned)b) << 16); }
__device__ __forceinline__ u32x4 pack8(f32x4 a, f32x4 b) { u32x4 w; w.x = cvtpk(a[0], a[1]); w.y = cvtpk(a[2], a[3]); w.z = cvtpk(b[0], b[1]); w.w = cvtpk(b[2], b[3]); return w; }
__device__ __forceinline__ void unpack8(u32x4 w, f32x4& a, f32x4& b) {
    a[0] = __uint_as_float(w.x << 16); a[1] = __uint_as_float(w.x & 0xffff0000u); a[2] = __uint_as_float(w.y << 16); a[3] = __uint_as_float(w.y & 0xffff0000u);
    b[0] = __uint_as_float(w.z << 16); b[1] = __uint_as_float(w.z & 0xffff0000u); b[2] = __uint_as_float(w.w << 16); b[3] = __uint_as_float(w.w & 0xffff0000u); }
__device__ __forceinline__ float dot4(f32x4 a) { return (a[0] * a[0] + a[1] * a[1]) + (a[2] * a[2] + a[3] * a[3]); }
__device__ __forceinline__ float sigmoidf_(float x) { return __builtin_amdgcn_rcpf(1.f + __builtin_amdgcn_exp2f(-x * LOG2E)); }
__device__ __forceinline__ int posof(int row) { return row < TP ? row : (row & (SSEQ - 1)); }

namespace pg8 {
constexpr int BM = 256, BK = 64, HALF = 128, HTB = HALF * BK * 2, STAGE_BYTES = 8 * HTB, NXCD = 8, WGM = 8;
__host__ __device__ __forceinline__ int lds_byte(int r, int c) { const int st = (r >> 4) * 2 + (c >> 5), rr = r & 15, cc = c & 31, ob = rr * 64 + cc * 2; return st * 1024 + (ob ^ (((ob >> 9) & 1) << 5)); }
__host__ __device__ __forceinline__ void stage_rc(int b, int& R, int& C) { const int st = b / 1024, sb = b % 1024, swz = sb ^ (((sb >> 9) & 1) << 5); R = (st >> 1) * 16 + swz / 64; C = (st & 1) * 32 + (swz % 64) / 2; }
__host__ __device__ __forceinline__ int perm32(int rho) { const int n = rho >> 4, i = rho & 15; return 8 * (i >> 2) + 4 * n + (i & 3); }

struct Unit { int pm, pn, sub; };
struct Gemm { const bf16_t* A0; const bf16_t* A1; const bf16_t* B0; const bf16_t* B1; int K; };

struct StaticOrder {
    int nM, nN, nwg, G, c, nsub;
    __device__ void init(int M, int N, int G_, int c_, int nsub_ = 1) { nM = M / BM; nN = N / BM; nwg = nM * nN; G = G_; c = c_; nsub = nsub_; }
    __device__ bool next(int i, Unit& u) const {
        const int it = (nsub == 2) ? (i >> 1) : i; u.sub = (nsub == 2) ? (i & 1) : 0;
        const long L = (long)it * G + c; if (L >= nwg) return false;
        int wgid = (int)L; { const int q = nwg / NXCD, r = nwg % NXCD, xcd = wgid % NXCD, off = wgid / NXCD; wgid = (xcd < r ? xcd * (q + 1) : r * (q + 1) + (xcd - r) * q) + off; }
        const int nig = WGM * nN, gid = wgid / nig, fm = gid * WGM, gsz = (nM - fm) < WGM ? (nM - fm) : WGM;
        u.pm = fm + ((wgid % nig) % gsz); u.pn = (wgid % nig) / gsz; return true;
    }
};

template <class Epi, class Sched>
__device__ __forceinline__ void gemm_phase(LAS unsigned char* lds, const Gemm g, const Sched& S, const Epi& E) {
    int tid_ = threadIdx.x; asm volatile("" : "+v"(tid_));
    const int tid = tid_, wid = __builtin_amdgcn_readfirstlane(tid >> 6), lane = tid & 63, wr = wid >> 2, wc = wid & 3, fr = lane & 15, fq = lane >> 4;
    const int K = g.K, nt = K / BK;
    unsigned voffA[2], voffB[2];
#pragma unroll
    for (int i = 0; i < 2; ++i) { int R, C; stage_rc(tid * 16 + i * 8192, R, C); const int Rb = (R & ~31) + perm32(R & 31);
        voffA[i] = (unsigned)(R * K + C) * 2u; voffB[i] = (unsigned)(Rb * K + C) * 2u; }
    const size_t kstep = (size_t)(BK * 2);
    const size_t hstep = (size_t)HALF * K * 2;
    const size_t tstep = 2 * hstep;
    const unsigned ldsw = (unsigned)wid * 1024u;
    const int aoff = lds_byte(wr * 64 + fr, fq * 8), boff = lds_byte(wc * 32 + fr, fq * 8);
#define PG8_SA(b, h) (((b) * 2 + (h)) * HTB)
#define PG8_SB(b, h) ((4 + (b) * 2 + (h)) * HTB)
#define PG8_STAGE(bufoff, gbase, voff) do { _Pragma("unroll") for (int _i = 0; _i < 2; ++_i) \
        __builtin_amdgcn_global_load_lds((const unsigned*)((const char*)(gbase) + (voff)[_i]), (LAS unsigned*)(lds + (bufoff) + ldsw + _i * 8192), 16, 0, 0); } while (0)
#define PG8_LDA(dst, b, h) do { _Pragma("unroll") for (int m = 0; m < 4; ++m) _Pragma("unroll") for (int k = 0; k < 2; ++k) dst[m][k] = *(const LAS bf16x8*)(lds + PG8_SA(b, h) + aoff + m * 2048 + k * 1024); } while (0)
#define PG8_LDB(dst, b, h) do { _Pragma("unroll") for (int n = 0; n < 2; ++n) _Pragma("unroll") for (int k = 0; k < 2; ++k) dst[n][k] = *(const LAS bf16x8*)(lds + PG8_SB(b, h) + boff + n * 2048 + k * 1024); } while (0)
#define PG8_MMA(ai, bj, At, Bt) do { __builtin_amdgcn_s_setprio(1); _Pragma("unroll") for (int m = 0; m < 4; ++m) _Pragma("unroll") for (int n = 0; n < 2; ++n) _Pragma("unroll") for (int k = 0; k < 2; ++k) \
        acc[ai][bj][m][n] = __builtin_amdgcn_mfma_f32_16x16x32_bf16(Bt[n][k], At[m][k], acc[ai][bj][m][n], 0, 0, 0); __builtin_amdgcn_s_setprio(0); } while (0)
#define PG8_WAIT_V(n) asm volatile("s_waitcnt vmcnt(" #n ")" ::: "memory")
#define PG8_WAIT_L(n) asm volatile("s_waitcnt lgkmcnt(" #n ")" ::: "memory")
#define PG8_BAR __builtin_amdgcn_s_barrier()
#define PG8_SCHED __builtin_amdgcn_sched_barrier(0)
    Unit cur, nxt; int ui = 0;
    if (!S.next(0, cur)) return;
    f32x4 acc[2][2][4][2];
#pragma unroll
    for (int a = 0; a < 2; ++a)
#pragma unroll
        for (int b = 0; b < 2; ++b)
#pragma unroll
            for (int m = 0; m < 4; ++m)
#pragma unroll
                for (int n = 0; n < 2; ++n) acc[a][b][m][n] = (f32x4){0.f, 0.f, 0.f, 0.f};
    bf16x8 At[4][2], B0[2][2], B1[2][2];
    const char* cA = (const char*)(cur.sub ? g.A1 : g.A0) + (size_t)cur.pm * tstep; const char* cB = (const char*)(cur.sub ? g.B1 : g.B0) + (size_t)cur.pn * tstep;
    PG8_STAGE(PG8_SB(0, 0), cB, voffB); PG8_STAGE(PG8_SB(0, 1), cB + hstep, voffB); PG8_STAGE(PG8_SA(0, 0), cA, voffA); PG8_STAGE(PG8_SA(0, 1), cA + hstep, voffA);
    if (wr == 1) PG8_BAR;
    PG8_WAIT_V(2); PG8_BAR;
    PG8_STAGE(PG8_SB(1, 0), cB + kstep, voffB); PG8_STAGE(PG8_SA(1, 0), cA + kstep, voffA); PG8_STAGE(PG8_SB(1, 1), cB + hstep + kstep, voffB);
    PG8_WAIT_V(6); PG8_BAR;
    for (;;) {
        const bool has_next = S.next(ui + 1, nxt);
        const char* nA = has_next ? (const char*)(nxt.sub ? g.A1 : g.A0) + (size_t)nxt.pm * tstep : cA; const char* nB = has_next ? (const char*)(nxt.sub ? g.B1 : g.B0) + (size_t)nxt.pn * tstep : cB;
#pragma unroll 1
        for (int t = 0; t < nt; t += 2) {
            const bool last = (t == nt - 2);
            const char* a1 = cA + (size_t)(t + 1) * kstep;
            const char* a2 = last ? nA : cA + (size_t)(t + 2) * kstep; const char* b2 = last ? nB : cB + (size_t)(t + 2) * kstep;
            const char* a3 = a2 + kstep; const char* b3 = b2 + kstep;
            PG8_LDB(B0, 0, 0); PG8_LDB(B1, 0, 1); PG8_SCHED; PG8_LDA(At, 0, 0); PG8_STAGE(PG8_SA(1, 1), a1 + hstep, voffA);
            PG8_WAIT_V(8); PG8_WAIT_L(0); PG8_BAR; PG8_MMA(0, 0, At, B0); PG8_MMA(0, 1, At, B1); PG8_BAR; PG8_SCHED;
            PG8_LDA(At, 0, 1); PG8_STAGE(PG8_SB(0, 0), b2, voffB); PG8_STAGE(PG8_SB(0, 1), b2 + hstep, voffB); PG8_STAGE(PG8_SA(0, 0), a2, voffA);
            PG8_WAIT_V(8); PG8_WAIT_L(0); PG8_BAR; PG8_MMA(1, 0, At, B0); PG8_MMA(1, 1, At, B1); PG8_BAR; PG8_SCHED;
            PG8_LDB(B0, 1, 0); PG8_LDB(B1, 1, 1); PG8_SCHED; PG8_LDA(At, 1, 0); PG8_STAGE(PG8_SA(0, 1), a2 + hstep, voffA);
            PG8_WAIT_V(8); PG8_WAIT_L(0); PG8_BAR; PG8_MMA(0, 0, At, B0); PG8_MMA(0, 1, At, B1); PG8_BAR; PG8_SCHED;
            PG8_LDA(At, 1, 1); PG8_STAGE(PG8_SB(1, 0), b3, voffB); PG8_STAGE(PG8_SB(1, 1), b3 + hstep, voffB); PG8_STAGE(PG8_SA(1, 0), a3, voffA);
            PG8_WAIT_V(8); PG8_WAIT_L(0); PG8_BAR; PG8_MMA(1, 0, At, B0); PG8_MMA(1, 1, At, B1); PG8_BAR; PG8_SCHED;
        }
        if (wr == 0) PG8_BAR;
        const bool keep = E(acc, cur, wr, wc, fr, fq);
        if (!has_next) break;
        if (!keep) {
#pragma unroll
        for (int a = 0; a < 2; ++a)
#pragma unroll
            for (int b = 0; b < 2; ++b)
#pragma unroll
                for (int m = 0; m < 4; ++m)
#pragma unroll
                    for (int n = 0; n < 2; ++n) acc[a][b][m][n] = (f32x4){0.f, 0.f, 0.f, 0.f};
        }
        cur = nxt; cA = nA; cB = nB; ++ui;
        if (wr == 1) PG8_BAR;
    }
    PG8_WAIT_V(0);
    PG8_BAR;
#undef PG8_SA
#undef PG8_SB
#undef PG8_STAGE
#undef PG8_LDA
#undef PG8_LDB
#undef PG8_MMA
#undef PG8_WAIT_V
#undef PG8_WAIT_L
#undef PG8_BAR
#undef PG8_SCHED
}
}
using pg8::Unit;
typedef f32x4 Acc[2][2][4][2];
#define EPI_BAR() do { asm volatile("s_waitcnt lgkmcnt(0)" ::: "memory"); __builtin_amdgcn_s_barrier(); asm volatile("" ::: "memory"); } while (0)

struct Epi1 {
    bf16_t *CQ, *CKV, *QD, *KD, *VD; float *KPE, *ssq, *sskv, *sspe; const float *gq, *gk;
    __device__ __forceinline__ bool operator()(Acc& acc, const Unit& u, int wr, int wc, int fr, int fq) const {
        const int pn = u.pn, row0 = u.pm * 256 + wr * 64 + fr;
        if (pn < 3 || pn >= 12) {
            bf16_t* base; int ld, colt; float* ss = nullptr;
            if (pn < 2) { base = CQ; ld = 512; colt = pn * 256; ss = ssq; } else if (pn == 2) { base = CKV; ld = 256; colt = 0; ss = sskv; } else { base = VD; ld = 1024; colt = (pn - 12) * 256; }
#pragma unroll
            for (int ai = 0; ai < 2; ++ai)
#pragma unroll
                for (int m = 0; m < 4; ++m) { const int row = row0 + ai * 128 + m * 16; float s = 0.f;
#pragma unroll
                    for (int bj = 0; bj < 2; ++bj) { const f32x4 v0 = acc[ai][bj][m][0], v1 = acc[ai][bj][m][1]; s += dot4(v0) + dot4(v1);
                        *(u32x4*)(base + (size_t)row * ld + colt + bj * 128 + wc * 32 + 8 * fq) = pack8(v0, v1); }
                    if (ss) { s += __shfl_xor(s, 16); s += __shfl_xor(s, 32); if (fq == 0) unsafeAtomicAdd(ss + row, s); } }
        } else if (pn == 3) {
            if (wc == 0) {
#pragma unroll
                for (int ai = 0; ai < 2; ++ai)
#pragma unroll
                    for (int m = 0; m < 4; ++m) { const int row = row0 + ai * 128 + m * 16; float s = 0.f;
#pragma unroll
                        for (int bj = 0; bj < 2; ++bj) { const f32x4 v0 = acc[ai][bj][m][0], v1 = acc[ai][bj][m][1]; s += dot4(v0) + dot4(v1);
                            float* p = KPE + (size_t)row * 64 + 32 * bj + 8 * fq; *(f32x4*)p = v0; *(f32x4*)(p + 4) = v1; }
                        s += __shfl_xor(s, 16); s += __shfl_xor(s, 32); if (fq == 0) sspe[row] = s; }
            }
        } else {
            const bool isq = pn < 8; bf16_t* base = isq ? QD : KD; const int colt = (pn - (isq ? 4 : 8)) * 256; const float* g = isq ? gq : gk; const float sc = isq ? SC_DIFF : 1.f;
            f32x4 gv[2][2];
#pragma unroll
            for (int bj = 0; bj < 2; ++bj)
#pragma unroll
                for (int n = 0; n < 2; ++n) gv[bj][n] = *(const f32x4*)(g + 32 * bj + 8 * fq + 4 * n);
#pragma unroll
            for (int ai = 0; ai < 2; ++ai)
#pragma unroll
                for (int m = 0; m < 4; ++m) { const int row = row0 + ai * 128 + m * 16; float s = 0.f;
#pragma unroll
                    for (int bj = 0; bj < 2; ++bj) s += dot4(acc[ai][bj][m][0]) + dot4(acc[ai][bj][m][1]);
                    s += __shfl_xor(s, 16); s += __shfl_xor(s, 32);
                    const float rs = rsqrtf(s * (1.f / 64.f) + EPS) * sc;
#pragma unroll
                    for (int bj = 0; bj < 2; ++bj) { const f32x4 v0 = acc[ai][bj][m][0] * rs * gv[bj][0], v1 = acc[ai][bj][m][1] * rs * gv[bj][1];
                        *(u32x4*)(base + (size_t)row * 1024 + colt + 64 * wc + 32 * bj + 8 * fq) = pack8(v0, v1); } }
        }
        return false;
    }
};
struct Epi2a {
    bf16_t* QM; const float* ssq; const float* gqn; const f32x2* rope; LAS float* red;
    __device__ __forceinline__ bool operator()(Acc& acc, const Unit& u, int wr, int wc, int fr, int fq) const {
        const int h = u.pn, rl0 = wr * 64 + fr;
        float ssv[2][4];
#pragma unroll
        for (int ai = 0; ai < 2; ++ai)
#pragma unroll
            for (int m = 0; m < 4; ++m) ssv[ai][m] = ssq[u.pm * 256 + rl0 + ai * 128 + m * 16];
#pragma unroll
        for (int ai = 0; ai < 2; ++ai)
#pragma unroll
            for (int m = 0; m < 4; ++m) { float s = 0.f;
#pragma unroll
                for (int bj = 0; bj < 2; ++bj) s += dot4(acc[ai][bj][m][0]) + dot4(acc[ai][bj][m][1]);
                s += __shfl_xor(s, 16); s += __shfl_xor(s, 32);
                if (fq == 0) red[(rl0 + ai * 128 + m * 16) * 4 + wc] = s; }
        EPI_BAR();
        if (wc < 3) {
            f32x4 gv[2][2];
#pragma unroll
            for (int bj = 0; bj < 2; ++bj)
#pragma unroll
                for (int n = 0; n < 2; ++n) gv[bj][n] = *(const f32x4*)(gqn + 64 * wc + 32 * bj + 8 * fq + 4 * n);
#pragma unroll
            for (int ai = 0; ai < 2; ++ai) {
#pragma unroll
              for (int mp = 0; mp < 2; ++mp) {
                f32x2 csv[2][8];
                if (wc == 2) {
#pragma unroll
                    for (int mm = 0; mm < 2; ++mm) { const f32x2* cs = rope + (size_t)posof(u.pm * 256 + rl0 + ai * 128 + (2 * mp + mm) * 16) * 32 + 8 * fq;
#pragma unroll
                        for (int e = 0; e < 8; ++e) csv[mm][e] = cs[e]; }
                    asm volatile("" ::: "memory");
                }
#pragma unroll
                for (int mm = 0; mm < 2; ++mm) { const int m = 2 * mp + mm; const int rl = rl0 + ai * 128 + m * 16, row = u.pm * 256 + rl;
                    const f32x4 t = *(const LAS f32x4*)(red + rl * 4); const float tot = (t[0] + t[1]) + t[2];
                    const float rq2 = 1.f / (ssv[ai][m] * (1.f / 512.f) + EPS);
                    const float f = sqrtf(rq2) * rsqrtf(rq2 * tot * (1.f / 192.f) + EPS) * SC_MLA;
                    bf16_t* dst = QM + (size_t)row * 1536 + h * 192;
                    if (wc < 2) {
#pragma unroll
                        for (int bj = 0; bj < 2; ++bj) *(u32x4*)(dst + 64 * wc + 32 * bj + 8 * fq) = pack8(acc[ai][bj][m][0] * f * gv[bj][0], acc[ai][bj][m][1] * f * gv[bj][1]);
                    } else {
                        f32x4 o1[2], o2[2];
#pragma unroll
                        for (int n = 0; n < 2; ++n) { const f32x4 x1 = acc[ai][0][m][n] * f * gv[0][n], x2 = acc[ai][1][m][n] * f * gv[1][n];
#pragma unroll
                            for (int j = 0; j < 4; ++j) { const f32x2 c = csv[mm][4 * n + j]; o1[n][j] = x1[j] * c.x - x2[j] * c.y; o2[n][j] = x2[j] * c.x + x1[j] * c.y; } }
                        *(u32x4*)(dst + 128 + 8 * fq) = pack8(o1[0], o1[1]); *(u32x4*)(dst + 160 + 8 * fq) = pack8(o2[0], o2[1]);
                    } }
              }
            }
        }
        return false;
    }
};
struct Epi2b {
    bf16_t *KM, *VM; const float *sskv, *sspe, *KPE, *gkn; const f32x2* rope; LAS float* red;
    __device__ __forceinline__ bool operator()(Acc& acc, const Unit& u, int wr, int wc, int fr, int fq) const {
        const int h = u.pn, rl0 = wr * 64 + fr;
        const int i0 = 8 * wc + 2 * fq;
        float skv[2][4], spe[2][4]; f32x2 xa[2][4], xb[2][4];
#pragma unroll
        for (int ai = 0; ai < 2; ++ai)
#pragma unroll
            for (int m = 0; m < 4; ++m) { const int row = u.pm * 256 + rl0 + ai * 128 + m * 16; skv[ai][m] = sskv[row]; spe[ai][m] = sspe[row];
                xa[ai][m] = *(const f32x2*)(KPE + (size_t)row * 64 + i0); xb[ai][m] = *(const f32x2*)(KPE + (size_t)row * 64 + 32 + i0);
            }
#pragma unroll
        for (int ai = 0; ai < 2; ++ai)
#pragma unroll
            for (int m = 0; m < 4; ++m) { float s = dot4(acc[ai][0][m][0]) + dot4(acc[ai][0][m][1]);
                s += __shfl_xor(s, 16); s += __shfl_xor(s, 32);
                if (fq == 0) red[(rl0 + ai * 128 + m * 16) * 4 + wc] = s; }
        EPI_BAR();
        f32x4 gv[2];
#pragma unroll
        for (int n = 0; n < 2; ++n) gv[n] = *(const f32x4*)(gkn + 32 * wc + 8 * fq + 4 * n);
        const f32x2 g1 = *(const f32x2*)(gkn + 128 + i0), g2 = *(const f32x2*)(gkn + 160 + i0);
#pragma unroll
        for (int ai = 0; ai < 2; ++ai)
#pragma unroll
            for (int m = 0; m < 4; ++m) { const int rl = rl0 + ai * 128 + m * 16, row = u.pm * 256 + rl;
                const f32x4 t = *(const LAS f32x4*)(red + rl * 4); const float tot = (t[0] + t[1]) + (t[2] + t[3]);
                const float rkv2 = 1.f / (skv[ai][m] * (1.f / 256.f) + EPS), rkv = sqrtf(rkv2);
                const float rk = rsqrtf((rkv2 * tot + spe[ai][m]) * (1.f / 192.f) + EPS), f = rkv * rk;
                bf16_t* dk = KM + (size_t)row * 1536 + h * 192;
                *(u32x4*)(dk + 32 * wc + 8 * fq) = pack8(acc[ai][0][m][0] * f * gv[0], acc[ai][0][m][1] * f * gv[1]);
                *(u32x4*)(VM + (size_t)row * 1024 + h * 128 + 32 * wc + 8 * fq) = pack8(acc[ai][1][m][0] * rkv, acc[ai][1][m][1] * rkv);
                const f32x2 x1 = xa[ai][m] * rk * g1, x2 = xb[ai][m] * rk * g2; const f32x2* cs = rope + (size_t)posof(row) * 32 + i0; const f32x2 c0 = cs[0], c1 = cs[1];
                *(unsigned*)(dk + 128 + i0) = cvtpk(x1.x * c0.x - x2.x * c0.y, x1.y * c1.x - x2.y * c1.y);
                *(unsigned*)(dk + 160 + i0) = cvtpk(x2.x * c0.x + x1.x * c0.y, x2.y * c1.x + x1.y * c1.y); }
        return false;
    }
};
struct Epi4 {
    bf16_t* SG;
    __device__ __forceinline__ bool operator()(Acc& acc, const Unit& u, int wr, int wc, int fr, int fq) const {
        const int row0 = u.pm * 256 + wr * 64 + fr, col0 = u.pn * 256 + wc * 32 + 8 * fq;
#pragma unroll
        for (int ai = 0; ai < 2; ++ai)
#pragma unroll
            for (int m = 0; m < 4; ++m)
#pragma unroll
                for (int bj = 0; bj < 2; ++bj) { f32x4 v0 = acc[ai][bj][m][0], v1 = acc[ai][bj][m][1];
#pragma unroll
                    for (int j = 0; j < 4; ++j) { v0[j] = sigmoidf_(v0[j]); v1[j] = sigmoidf_(v1[j]); }
                    *(u32x4*)(SG + (size_t)(row0 + ai * 128 + m * 16) * 4096 + col0 + bj * 128) = pack8(v0, v1); }
        return false;
    }
};
struct Epi5 {
    const bf16_t* SG; bf16_t* MG;
    __device__ __forceinline__ bool operator()(Acc& acc, const Unit& u, int wr, int wc, int fr, int fq) const {
        const int row0 = u.pm * 256 + wr * 64 + fr, col0 = u.pn * 256 + wc * 32 + 8 * fq;
#pragma unroll
        for (int ai = 0; ai < 2; ++ai) {
            u32x4 sav[4][2], sbv[4][2];
#pragma unroll
            for (int m = 0; m < 4; ++m)
#pragma unroll
                for (int bj = 0; bj < 2; ++bj) { const bf16_t* sg = SG + (size_t)(row0 + ai * 128 + m * 16) * 4096 + col0 + bj * 128; sbv[m][bj] = *(const u32x4*)(sg + 2048); if (u.sub == 0) sav[m][bj] = *(const u32x4*)sg; }
            asm volatile("" ::: "memory");
#pragma unroll
            for (int m = 0; m < 4; ++m)
#pragma unroll
                for (int bj = 0; bj < 2; ++bj) { const size_t row = row0 + ai * 128 + m * 16; f32x4 b0, b1; unpack8(sbv[m][bj], b0, b1);
                    if (u.sub == 0) { f32x4 a0, a1; unpack8(sav[m][bj], a0, a1);
#pragma unroll
                        for (int j = 0; j < 4; ++j) { acc[ai][bj][m][0][j] *= a0[j] * __builtin_amdgcn_rcpf(b0[j]); acc[ai][bj][m][1][j] *= a1[j] * __builtin_amdgcn_rcpf(b1[j]); }
                    } else *(u32x4*)(MG + row * 2048 + col0 + bj * 128) = pack8(acc[ai][bj][m][0] * b0, acc[ai][bj][m][1] * b1); }
        }
        return u.sub == 0;
    }
};
struct Epi6 {
    const float *xp, *xs; float* out; bf16_t* X1b; float* ss2;
    __device__ __forceinline__ bool operator()(Acc& acc, const Unit& u, int wr, int wc, int fr, int fq) const {
        const int row0 = u.pm * 256 + wr * 64 + fr, col0 = u.pn * 256 + wc * 32 + 8 * fq;
#pragma unroll
        for (int ai = 0; ai < 2; ++ai) {
            f32x4 xv[4][2][2];
#pragma unroll
            for (int m = 0; m < 4; ++m) { const int row = row0 + ai * 128 + m * 16; const float* xr = (row < TP ? xp + (size_t)row * DM : xs + (size_t)(row - TP) * DM) + col0;
#pragma unroll
                for (int bj = 0; bj < 2; ++bj) { xv[m][bj][0] = *(const f32x4*)(xr + bj * 128); xv[m][bj][1] = *(const f32x4*)(xr + bj * 128 + 4); } }
            asm volatile("" ::: "memory");
#pragma unroll
            for (int m = 0; m < 4; ++m) { const int row = row0 + ai * 128 + m * 16; float s = 0.f;
#pragma unroll
                for (int bj = 0; bj < 2; ++bj) { const f32x4 v0 = xv[m][bj][0] + acc[ai][bj][m][0], v1 = xv[m][bj][1] + acc[ai][bj][m][1];
                    s += dot4(v0) + dot4(v1);
                    *(u32x4*)(X1b + (size_t)row * DM + col0 + bj * 128) = pack8(v0, v1); }
                s += __shfl_xor(s, 16); s += __shfl_xor(s, 32); if (fq == 0) unsafeAtomicAdd(ss2 + row, s); }
        }
        return false;
    }
};
struct Epi7 {
    bf16_t* ACT; const float* ss2; int rowoff;
    __device__ __forceinline__ bool operator()(Acc& acc, const Unit& u, int wr, int wc, int fr, int fq) const {
        const int row0 = u.pm * 256 + wr * 64 + fr, col0 = u.pn * 128 + wc * 32 + 8 * fq;
        float ssv[2][4];
#pragma unroll
        for (int ai = 0; ai < 2; ++ai)
#pragma unroll
            for (int m = 0; m < 4; ++m) ssv[ai][m] = ss2[rowoff + row0 + ai * 128 + m * 16];
        asm volatile("" ::: "memory");
#pragma unroll
        for (int ai = 0; ai < 2; ++ai)
#pragma unroll
            for (int m = 0; m < 4; ++m) { const int row = row0 + ai * 128 + m * 16; const float rs = rsqrtf(ssv[ai][m] * (1.f / 2048.f) + EPS); f32x4 o[2];
#pragma unroll
                for (int n = 0; n < 2; ++n)
#pragma unroll
                    for (int j = 0; j < 4; ++j) { const float gt = acc[ai][0][m][n][j] * rs, up = acc[ai][1][m][n][j] * rs; o[n][j] = gt * sigmoidf_(gt) * up; }
                *(u32x4*)(ACT + (size_t)row * DFF + col0) = pack8(o[0], o[1]); }
        return false;
    }
};
struct Epi8 {
    float* out; const bf16_t* X1b; int rowoff;
    __device__ __forceinline__ bool operator()(Acc& acc, const Unit& u, int wr, int wc, int fr, int fq) const {
        const int row0 = rowoff + u.pm * 256 + wr * 64 + fr, col0 = u.pn * 256 + wc * 32 + 8 * fq;
#pragma unroll
        for (int ai = 0; ai < 2; ++ai) {
            u32x4 xv[4][2];
#pragma unroll
            for (int m = 0; m < 4; ++m)
#pragma unroll
                for (int bj = 0; bj < 2; ++bj) xv[m][bj] = *(const u32x4*)(X1b + (size_t)(row0 + ai * 128 + m * 16) * DM + col0 + bj * 128);
            asm volatile("" ::: "memory");
#pragma unroll
            for (int m = 0; m < 4; ++m)
#pragma unroll
                for (int bj = 0; bj < 2; ++bj) { float* o = out + (size_t)(row0 + ai * 128 + m * 16) * DM + col0 + bj * 128;
                    f32x4 x0, x1; unpack8(xv[m][bj], x0, x1); *(f32x4*)o = x0 + acc[ai][bj][m][0]; *(f32x4*)(o + 4) = x1 + acc[ai][bj][m][1]; }
        }
        return false;
    }
};

#ifndef ATTN_FN0
#define ATTN_FN0 attn_unit_s
#endif
#ifndef ATTN_FN1
#define ATTN_FN1 attn_unit
#endif
namespace att {
constexpr float THRL = 11.5f;
#define SBAR() __builtin_amdgcn_sched_barrier(0)
__device__ __forceinline__ int crow(int r, int hi) { return (r & 3) + 8 * (r >> 2) + 4 * hi; }
__device__ __forceinline__ int v_st(int k, int c) { const int kk = (k & ~0xC) | ((k & 4) << 1) | ((k & 8) >> 1); return ((kk >> 3) * 4 + (c >> 5)) * 512 + ((kk & 7) * 32 + (c & 31)) * 2; }
__device__ __forceinline__ int v_rd_base(int lane) { return ((lane & 3) << 3) | (((lane >> 2) & 3) << 6) | (((lane >> 4) & 1) << 5) | (((lane >> 5) & 1) << 8); }
constexpr int v_rd_off(int d0, int ks, int half) { return d0 * 512 + ks * 4096 + half * 2048; }
template <int OFF> __device__ __forceinline__ s16x4 tr_read(int vb) { s16x4 r; asm volatile("ds_read_b64_tr_b16 %0, %1 offset:%2" : "=&v"(r) : "v"(vb), "i"(OFF) : "memory"); return r; }
template <int D0> __device__ __forceinline__ void pv_one(f32x16& od, int vb, bf16x8 pa0, bf16x8 pa1, bf16x8 pa2, bf16x8 pa3) {
    const s16x4 l0 = tr_read<v_rd_off(D0, 0, 0)>(vb), h0 = tr_read<v_rd_off(D0, 0, 1)>(vb), l1 = tr_read<v_rd_off(D0, 1, 0)>(vb), h1 = tr_read<v_rd_off(D0, 1, 1)>(vb);
    const s16x4 l2 = tr_read<v_rd_off(D0, 2, 0)>(vb), h2 = tr_read<v_rd_off(D0, 2, 1)>(vb), l3 = tr_read<v_rd_off(D0, 3, 0)>(vb), h3 = tr_read<v_rd_off(D0, 3, 1)>(vb);
    asm volatile("s_waitcnt lgkmcnt(0)" ::: "memory"); SBAR();
#define PK(L, H) (bf16x8){L[0], L[1], L[2], L[3], H[0], H[1], H[2], H[3]}
    od = __builtin_amdgcn_mfma_f32_32x32x16_bf16(pa0, PK(l0, h0), od, 0, 0, 0);
    od = __builtin_amdgcn_mfma_f32_32x32x16_bf16(pa1, PK(l1, h1), od, 0, 0, 0);
    od = __builtin_amdgcn_mfma_f32_32x32x16_bf16(pa2, PK(l2, h2), od, 0, 0, 0);
    od = __builtin_amdgcn_mfma_f32_32x32x16_bf16(pa3, PK(l3, h3), od, 0, 0, 0);
#undef PK
}
template <int D0> __device__ __forceinline__ void v_rd8(s16x4 (&f)[8], int vb) {
    f[0] = tr_read<v_rd_off(D0, 0, 0)>(vb); f[1] = tr_read<v_rd_off(D0, 0, 1)>(vb); f[2] = tr_read<v_rd_off(D0, 1, 0)>(vb); f[3] = tr_read<v_rd_off(D0, 1, 1)>(vb);
    f[4] = tr_read<v_rd_off(D0, 2, 0)>(vb); f[5] = tr_read<v_rd_off(D0, 2, 1)>(vb); f[6] = tr_read<v_rd_off(D0, 3, 0)>(vb); f[7] = tr_read<v_rd_off(D0, 3, 1)>(vb); }
__device__ __forceinline__ void pv_mm(f32x16& od, const s16x4 (&f)[8], bf16x8 pa0, bf16x8 pa1, bf16x8 pa2, bf16x8 pa3) {
#define PK(L, H) (bf16x8){L[0], L[1], L[2], L[3], H[0], H[1], H[2], H[3]}
    od = __builtin_amdgcn_mfma_f32_32x32x16_bf16(pa0, PK(f[0], f[1]), od, 0, 0, 0);
    od = __builtin_amdgcn_mfma_f32_32x32x16_bf16(pa1, PK(f[2], f[3]), od, 0, 0, 0);
    od = __builtin_amdgcn_mfma_f32_32x32x16_bf16(pa2, PK(f[4], f[5]), od, 0, 0, 0);
    od = __builtin_amdgcn_mfma_f32_32x32x16_bf16(pa3, PK(f[6], f[7]), od, 0, 0, 0);
#undef PK
}
__device__ __forceinline__ void pv_d0_pf(f32x16* o, int vb, bf16x8 pa0, bf16x8 pa1, bf16x8 pa2, bf16x8 pa3) {
    s16x4 fa[8], fb[8];
    v_rd8<0>(fa, vb); v_rd8<1>(fb, vb);
    asm volatile("s_waitcnt lgkmcnt(8)" ::: "memory"); SBAR(); pv_mm(o[0], fa, pa0, pa1, pa2, pa3); SBAR();
    v_rd8<2>(fa, vb);
    asm volatile("s_waitcnt lgkmcnt(8)" ::: "memory"); SBAR(); pv_mm(o[1], fb, pa0, pa1, pa2, pa3); SBAR();
    v_rd8<3>(fb, vb);
    asm volatile("s_waitcnt lgkmcnt(8)" ::: "memory"); SBAR(); pv_mm(o[2], fa, pa0, pa1, pa2, pa3); SBAR();
    asm volatile("s_waitcnt lgkmcnt(0)" ::: "memory"); SBAR(); pv_mm(o[3], fb, pa0, pa1, pa2, pa3);
}
__device__ __forceinline__ void pv_d0(f32x16* o, int vb, bf16x8 pa0, bf16x8 pa1, bf16x8 pa2, bf16x8 pa3) {
    pv_one<0>(o[0], vb, pa0, pa1, pa2, pa3); pv_one<1>(o[1], vb, pa0, pa1, pa2, pa3); pv_one<2>(o[2], vb, pa0, pa1, pa2, pa3); pv_one<3>(o[3], vb, pa0, pa1, pa2, pa3);
}
template <int MODE>
__device__ __forceinline__ void partialSM(f32x16& p0, f32x16& p1, bool near, const float* lut, int k0, int qpos, int hi, float sh) {
    if (MODE == 1) {
        if (near) { const int rb = k0 - qpos + 128 + 4 * hi;
#pragma unroll
            for (int r = 0; r < 16; ++r) { const int i0 = rb + (r & 3) + 8 * (r >> 2); const int a = min(max(i0, 0), 256), b = min(max(i0 + 32, 0), 256); p0[r] += lut[a]; p1[r] += lut[b]; } }
    }
#pragma unroll
    for (int r = 0; r < 16; ++r) p0[r] = __builtin_amdgcn_exp2f(p0[r]);
}
__device__ __forceinline__ void finishSM(f32x16& p0, f32x16& p1, float& l_reg, bf16x8& pa0, bf16x8& pa1, bf16x8& pa2, bf16x8& pa3) {
#pragma unroll
    for (int r = 0; r < 16; ++r) p1[r] = __builtin_amdgcn_exp2f(p1[r]);
    float ps = 0;
#pragma unroll
    for (int r = 0; r < 16; ++r) ps += p0[r];
#pragma unroll
    for (int r = 0; r < 16; ++r) ps += p1[r];
    { auto rr = __builtin_amdgcn_permlane32_swap(__float_as_uint(ps), __float_as_uint(ps), false, false); ps = __uint_as_float(rr[0]) + __uint_as_float(rr[1]); }
    l_reg += ps;
#define PK4(P, BASE, OUT) do { unsigned a0 = cvtpk(P[BASE + 0], P[BASE + 1]), a1 = cvtpk(P[BASE + 2], P[BASE + 3]);   \
    unsigned b0 = cvtpk(P[BASE + 4], P[BASE + 5]), b1 = cvtpk(P[BASE + 6], P[BASE + 7]);                              \
    auto r0 = __builtin_amdgcn_permlane32_swap(a0, b0, false, false); auto r1 = __builtin_amdgcn_permlane32_swap(a1, b1, false, false); \
    u32x4 w = {r0[0], r1[0], r0[1], r1[1]}; OUT = *reinterpret_cast<bf16x8*>(&w); } while (0)
    PK4(p0, 0, pa0); PK4(p0, 8, pa1); PK4(p1, 0, pa2); PK4(p1, 8, pa3);
#undef PK4
}
template <int MODE>
__device__ __forceinline__ void nearSM(f32x16& p0, f32x16& p1, bool near, const float* lut, int k0, int qpos, int hi) {
    if (MODE == 1) {
        if (near) { const int rb = k0 - qpos + 128 + 4 * hi;
#pragma unroll
            for (int r = 0; r < 16; ++r) { const int i0 = rb + (r & 3) + 8 * (r >> 2); const int a = min(max(i0, 0), 256), b = min(max(i0 + 32, 0), 256); p0[r] += lut[a]; p1[r] += lut[b]; } }
    }
}
__device__ __forceinline__ void expall(f32x16& p0, f32x16& p1) {
#pragma unroll
    for (int r = 0; r < 16; ++r) p0[r] = __builtin_amdgcn_exp2f(p0[r]);
#pragma unroll
    for (int r = 0; r < 16; ++r) p1[r] = __builtin_amdgcn_exp2f(p1[r]);
}
__device__ __forceinline__ void finishSM_ne(f32x16& p0, f32x16& p1, float& l_reg, bf16x8& pa0, bf16x8& pa1, bf16x8& pa2, bf16x8& pa3) {
    float ps = 0;
#pragma unroll
    for (int r = 0; r < 16; ++r) ps += p0[r];
#pragma unroll
    for (int r = 0; r < 16; ++r) ps += p1[r];
    { auto rr = __builtin_amdgcn_permlane32_swap(__float_as_uint(ps), __float_as_uint(ps), false, false); ps = __uint_as_float(rr[0]) + __uint_as_float(rr[1]); }
    l_reg += ps;
#define PK4(P, BASE, OUT) do { unsigned a0 = cvtpk(P[BASE + 0], P[BASE + 1]), a1 = cvtpk(P[BASE + 2], P[BASE + 3]);   \
    unsigned b0 = cvtpk(P[BASE + 4], P[BASE + 5]), b1 = cvtpk(P[BASE + 6], P[BASE + 7]);                              \
    auto r0 = __builtin_amdgcn_permlane32_swap(a0, b0, false, false); auto r1 = __builtin_amdgcn_permlane32_swap(a1, b1, false, false); \
    u32x4 w = {r0[0], r1[0], r0[1], r1[1]}; OUT = *reinterpret_cast<bf16x8*>(&w); } while (0)
    PK4(p0, 0, pa0); PK4(p0, 8, pa1); PK4(p1, 0, pa2); PK4(p1, 8, pa3);
#undef PK4
}
__device__ __forceinline__ void pv_d0_sm(f32x16* o, int vb, bf16x8 pa0, bf16x8 pa1, bf16x8 pa2, bf16x8 pa3, f32x16& x0, f32x16& x1) {
    s16x4 fa[8], fb[8];
    v_rd8<0>(fa, vb); v_rd8<1>(fb, vb);
    asm volatile("s_waitcnt lgkmcnt(8)" ::: "memory"); SBAR();
#pragma unroll
    for (int r = 0; r < 8; ++r) x0[r] = __builtin_amdgcn_exp2f(x0[r]);
    pv_mm(o[0], fa, pa0, pa1, pa2, pa3); SBAR();
    v_rd8<2>(fa, vb);
    asm volatile("s_waitcnt lgkmcnt(8)" ::: "memory"); SBAR();
#pragma unroll
    for (int r = 8; r < 16; ++r) x0[r] = __builtin_amdgcn_exp2f(x0[r]);
    pv_mm(o[1], fb, pa0, pa1, pa2, pa3); SBAR();
    v_rd8<3>(fb, vb);
    asm volatile("s_waitcnt lgkmcnt(8)" ::: "memory"); SBAR();
#pragma unroll
    for (int r = 0; r < 8; ++r) x1[r] = __builtin_amdgcn_exp2f(x1[r]);
    pv_mm(o[2], fa, pa0, pa1, pa2, pa3); SBAR();
    asm volatile("s_waitcnt lgkmcnt(0)" ::: "memory"); SBAR();
#pragma unroll
    for (int r = 8; r < 16; ++r) x1[r] = __builtin_amdgcn_exp2f(x1[r]);
    pv_mm(o[3], fb, pa0, pa1, pa2, pa3);
}
__device__ __forceinline__ int tile_cls(int k0, int qlo) { return (k0 + 63 <= qlo - 128) ? 0 : ((k0 >= qlo + 31 + 128) ? 2 : 1); }
template <int MODE> struct Cfg;
template <> struct Cfg<0> { static constexpr int DQK = 192, KROWB = 400, LDQ = 1536, LDK = 1536, LDV = 1024, LDO = 1024, NKS = 3, SDEPTH = 1; };
template <> struct Cfg<1> { static constexpr int DQK = 64,  KROWB = 272, LDQ = 1024, LDK = 1024, LDV = 1024, LDO = 1024, NKS = 2, SDEPTH = 1; };

template <int MODE>
__device__ __forceinline__ void qkt(f32x16& p0, f32x16& p1, const char* Ks, const bf16x8* qr, int r32, int hi, int kcol0, const f32x16& cinit) {
    constexpr int KROWB = Cfg<MODE>::KROWB, NQ = Cfg<MODE>::DQK / 16;
#pragma unroll
    for (int d0 = 0; d0 < NQ; ++d0) { const int cb = kcol0 + (d0 * 16 + hi * 8) * 2;
        bf16x8 b0 = *reinterpret_cast<const bf16x8*>(Ks + r32 * KROWB + cb);
        bf16x8 b1 = *reinterpret_cast<const bf16x8*>(Ks + (32 + r32) * KROWB + cb);
        p0 = __builtin_amdgcn_mfma_f32_32x32x16_bf16(b0, qr[d0], d0 == 0 ? cinit : p0, 0, 0, 0);
        p1 = __builtin_amdgcn_mfma_f32_32x32x16_bf16(b1, qr[d0], d0 == 0 ? cinit : p1, 0, 0, 0);
        if ((d0 & 3) == 3 && d0 + 1 < NQ) SBAR(); }
}

template <int MODE>
__device__ __forceinline__ void attn_unit(const bf16_t* Qb, const bf16_t* Kh, const bf16_t* Vh, bf16_t* Ob, int seq, int qpos0, float lam, const float* gsub, char* lds, float* wscr, const float* lut, float bound) {
    using C = Cfg<MODE>;
    constexpr int SHM_V = 64 * 128 * 2, SHM_K = 64 * C::KROWB, NQ = C::DQK / 16, SDEPTH = C::SDEPTH, NKS = C::NKS;
    int tid_ = threadIdx.x; asm volatile("" : "+v"(tid_));
    const int tid = tid_, wid = __builtin_amdgcn_readfirstlane(tid >> 6), lane = tid & 63, r32 = lane & 31, hi = lane >> 5;
    char* V_lds = lds; char* K_lds = lds + 2 * SHM_V;
    float* li_l = wscr + wid * 64;
    const int wrow = MODE ? (wid & 3) * 32 : wid * 32, kcol0 = MODE ? (wid >> 2) * 128 : 0;
    const int qlo = qpos0 + wrow, qpos = qlo + r32;
    float l_reg = 0; f32x16 o[4] = {}; bf16x8 qr[NQ]; f32x16 cinit; int ccls = -2; float shc = 0.f;
#define SETC(k0_) do { const int c_ = MODE ? tile_cls((k0_), qlo) : 0; if (c_ != ccls) { const float v_ = (MODE ? (c_ == 0 ? lut[0] : (c_ == 2 ? lut[256] : 0.f)) : 0.f) - bound; \
    _Pragma("unroll") for (int r_ = 0; r_ < 16; ++r_) cinit[r_] = v_; shc = v_; ccls = c_; } } while (0)
    const bf16_t* Qw = Qb + (long)(wrow + r32) * C::LDQ + (MODE ? (wid >> 2) * 64 : 0) + hi * 8;
#pragma unroll
    for (int d0 = 0; d0 < NQ; ++d0) qr[d0] = *reinterpret_cast<const bf16x8*>(Qw + d0 * 16);
    const int sr = tid >> 4, sc = (tid & 15) * 8, vst0 = v_st(sr, sc), vst1 = v_st(32 + sr, sc);
    int krow[NKS], kch[NKS];
#pragma unroll
    for (int i = 0; i < NKS; ++i) { if (MODE == 0) { const int id = tid + 512 * i; krow[i] = id / 24; kch[i] = id % 24; } else { krow[i] = sr + 32 * i; kch[i] = tid & 15; } }
    const int vb0 = (int)(uintptr_t)V_lds + v_rd_base(lane);
    struct { bf16x8 vs0, vs1, ks[NKS]; } sr_[SDEPTH];
#define SLOAD(i, k0) do { sr_[i].vs0 = *(const bf16x8*)(&Vh[(long)((k0) + sr) * C::LDV + sc]); sr_[i].vs1 = *(const bf16x8*)(&Vh[(long)((k0) + 32 + sr) * C::LDV + sc]); \
    _Pragma("unroll") for (int q_ = 0; q_ < NKS; ++q_) sr_[i].ks[q_] = *(const bf16x8*)(&Kh[(long)((k0) + krow[q_]) * C::LDK + kch[q_] * 8]); } while (0)
#define SWRITE(b, i) do { *(bf16x8*)(V_lds + (b) * SHM_V + vst0) = sr_[i].vs0; *(bf16x8*)(V_lds + (b) * SHM_V + vst1) = sr_[i].vs1; \
    _Pragma("unroll") for (int q_ = 0; q_ < NKS; ++q_) *(bf16x8*)(K_lds + (b) * SHM_K + krow[q_] * C::KROWB + kch[q_] * 16) = sr_[i].ks[q_]; } while (0)
#define SWAIT() do { if constexpr (SDEPTH == 2) asm volatile("s_waitcnt vmcnt(4)" ::: "memory"); else asm volatile("s_waitcnt vmcnt(0)" ::: "memory"); } while (0)
    f32x16 pA0, pA1, pB0, pB1; bf16x8 pa0, pa1, pa2, pa3; const int NT = seq / 64;
    constexpr int SE = 0, SO = SDEPTH - 1;
    SLOAD(SE, 0); asm volatile("s_waitcnt vmcnt(0)" ::: "memory"); SWRITE(0, SE); __syncthreads();
    SETC(0); qkt<MODE>(pA0, pA1, K_lds, qr, r32, hi, kcol0, cinit); nearSM<MODE>(pA0, pA1, ccls == 1, lut, 0, qpos, hi); expall(pA0, pA1);
    SLOAD(SO, 64); if constexpr (SDEPTH == 2) { if (2 < NT) SLOAD(SE, 2 * 64); }
    SWAIT(); SWRITE(1, SO); __syncthreads();
    for (int j = 1; j + 1 < NT; j += 2) {
        SBAR(); SETC(j * 64); qkt<MODE>(pB0, pB1, K_lds + SHM_K, qr, r32, hi, kcol0, cinit);
        finishSM_ne(pA0, pA1, l_reg, pa0, pa1, pa2, pa3); SBAR();
        SLOAD(SO, (j + SDEPTH) * 64); SBAR();
        nearSM<MODE>(pB0, pB1, ccls == 1, lut, j * 64, qpos, hi); pv_d0_sm(o, vb0, pa0, pa1, pa2, pa3, pB0, pB1);
        __syncthreads(); SWAIT(); SWRITE(0, SE);
        __syncthreads();
        SBAR(); SETC((j + 1) * 64); qkt<MODE>(pA0, pA1, K_lds, qr, r32, hi, kcol0, cinit);
        finishSM_ne(pB0, pB1, l_reg, pa0, pa1, pa2, pa3); SBAR();
        if (SDEPTH == 1 || j + 3 < NT) SLOAD(SE, (j + 1 + SDEPTH) * 64); SBAR();
        nearSM<MODE>(pA0, pA1, ccls == 1, lut, (j + 1) * 64, qpos, hi); pv_d0_sm(o, vb0 + SHM_V, pa0, pa1, pa2, pa3, pA0, pA1);
        __syncthreads(); SWAIT(); SWRITE(1, SO);
        __syncthreads();
    }
    SBAR(); SETC((NT - 1) * 64); qkt<MODE>(pB0, pB1, K_lds + SHM_K, qr, r32, hi, kcol0, cinit);
    finishSM_ne(pA0, pA1, l_reg, pa0, pa1, pa2, pa3); SBAR();
    nearSM<MODE>(pB0, pB1, ccls == 1, lut, (NT - 1) * 64, qpos, hi); pv_d0_sm(o, vb0, pa0, pa1, pa2, pa3, pB0, pB1);
    __syncthreads();
    finishSM_ne(pB0, pB1, l_reg, pa0, pa1, pa2, pa3); SBAR();
    pv_d0_pf(o, vb0 + SHM_V, pa0, pa1, pa2, pa3);
    if (hi == 0) li_l[r32] = l_reg; asm volatile("s_waitcnt lgkmcnt(0)" ::: "memory");
    float rli[16];
#pragma unroll
    for (int r = 0; r < 16; ++r) rli[r] = __builtin_amdgcn_rcpf(li_l[crow(r, hi)]);
    bf16_t* Ow = Ob + (long)wrow * C::LDO;
    if (MODE == 0) {
#pragma unroll
        for (int r = 0; r < 16; ++r) { const int orow = crow(r, hi);
#pragma unroll
            for (int d0 = 0; d0 < 4; ++d0) Ow[(long)orow * C::LDO + d0 * 32 + r32] = (bf16_t)(cvtpk(o[d0][r] * rli[r], 0.f) & 0xffffu); }
        __syncthreads();
    } else {
        __syncthreads();
        float* X = (float*)lds + (wid & 3) * 4096 + lane;
        if (wid >= 4) {
#pragma unroll
            for (int d0 = 0; d0 < 4; ++d0)
#pragma unroll
                for (int r = 0; r < 16; ++r) X[(d0 * 16 + r) * 64] = o[d0][r] * rli[r];
        }
        __syncthreads();
        if (wid < 4) {
            float ss[16];
#pragma unroll
            for (int r = 0; r < 16; ++r) ss[r] = 0.f;
#pragma unroll
            for (int d0 = 0; d0 < 4; ++d0)
#pragma unroll
                for (int r = 0; r < 16; ++r) { const float v = o[d0][r] * rli[r] - lam * X[(d0 * 16 + r) * 64]; o[d0][r] = v; ss[r] += v * v; }
#pragma unroll
            for (int r = 0; r < 16; ++r) { float s = ss[r]; s += __shfl_xor(s, 1); s += __shfl_xor(s, 2); s += __shfl_xor(s, 4); s += __shfl_xor(s, 8); s += __shfl_xor(s, 16);
                ss[r] = rsqrtf(s * (1.f / 128.f) + EPS) * 0.8f; }
#pragma unroll
            for (int d0 = 0; d0 < 4; ++d0) { const float gsv = gsub[d0 * 32 + r32];
#pragma unroll
                for (int r = 0; r < 16; ++r) Ow[(long)crow(r, hi) * C::LDO + d0 * 32 + r32] = (bf16_t)(cvtpk(o[d0][r] * ss[r] * gsv, 0.f) & 0xffffu); }
        }
        __syncthreads();
    }
#undef SLOAD
#undef SWRITE
#undef SWAIT
#undef SETC
}

template <int MODE>
__device__ __forceinline__ void attn_unit_s(const bf16_t* Qb, const bf16_t* Kh, const bf16_t* Vh, bf16_t* Ob, int seq, int qpos0, float lam, const float* gsub, char* lds, float* wscr, const float* lut, float bound) {
    using C = Cfg<MODE>;
    constexpr int SHM_V = 64 * 128 * 2, SHM_K = 64 * C::KROWB, NQ = C::DQK / 16, NKS = C::NKS;
    int tid_ = threadIdx.x; asm volatile("" : "+v"(tid_));
    const int tid = tid_, wid = __builtin_amdgcn_readfirstlane(tid >> 6), lane = tid & 63, r32 = lane & 31, hi = lane >> 5;
    char* V_lds = lds; char* K_lds = lds + 2 * SHM_V;
    float* li_l = wscr + wid * 64;
    const int wrow = MODE ? (wid & 3) * 32 : wid * 32, kcol0 = MODE ? (wid >> 2) * 128 : 0;
    const int qlo = qpos0 + wrow, qpos = qlo + r32;
    float l_reg = 0; f32x16 o[4] = {}; bf16x8 qr[NQ]; f32x16 cinit; int ccls = -2; float shc = 0.f;
#define SETC(k0_) do { const int c_ = MODE ? tile_cls((k0_), qlo) : 0; if (c_ != ccls) { const float v_ = (MODE ? (c_ == 0 ? lut[0] : (c_ == 2 ? lut[256] : 0.f)) : 0.f) - bound; \
    _Pragma("unroll") for (int r_ = 0; r_ < 16; ++r_) cinit[r_] = v_; shc = v_; ccls = c_; } } while (0)
    const bf16_t* Qw = Qb + (long)(wrow + r32) * C::LDQ + (MODE ? (wid >> 2) * 64 : 0) + hi * 8;
#pragma unroll
    for (int d0 = 0; d0 < NQ; ++d0) qr[d0] = *reinterpret_cast<const bf16x8*>(Qw + d0 * 16);
    const int sr = tid >> 4, sc = (tid & 15) * 8, vst0 = v_st(sr, sc), vst1 = v_st(32 + sr, sc);
    int krow[NKS], kch[NKS];
#pragma unroll
    for (int i = 0; i < NKS; ++i) { if (MODE == 0) { const int id = tid + 512 * i; krow[i] = id / 24; kch[i] = id % 24; } else { krow[i] = sr + 32 * i; kch[i] = tid & 15; } }
    const int vb0 = (int)(uintptr_t)V_lds + v_rd_base(lane);
    bf16x8 vs0, vs1, ks[NKS];
#define SLOAD(k0) do { vs0 = *(const bf16x8*)(&Vh[(long)((k0) + sr) * C::LDV + sc]); vs1 = *(const bf16x8*)(&Vh[(long)((k0) + 32 + sr) * C::LDV + sc]); \
    _Pragma("unroll") for (int q_ = 0; q_ < NKS; ++q_) ks[q_] = *(const bf16x8*)(&Kh[(long)((k0) + krow[q_]) * C::LDK + kch[q_] * 8]); } while (0)
#define SWRITE(b) do { *(bf16x8*)(V_lds + (b) * SHM_V + vst0) = vs0; *(bf16x8*)(V_lds + (b) * SHM_V + vst1) = vs1; \
    _Pragma("unroll") for (int q_ = 0; q_ < NKS; ++q_) *(bf16x8*)(K_lds + (b) * SHM_K + krow[q_] * C::KROWB + kch[q_] * 16) = ks[q_]; } while (0)
    f32x16 p0, p1; bf16x8 pa0, pa1, pa2, pa3; const int NT = seq / 64;
    SLOAD(0); asm volatile("s_waitcnt vmcnt(0)" ::: "memory"); SWRITE(0); __syncthreads();
#pragma unroll 1
    for (int j = 0; j < NT; ++j) {
        const int b = j & 1;
        if (j + 1 < NT) SLOAD((j + 1) * 64);
        SBAR();
        SETC(j * 64); qkt<MODE>(p0, p1, K_lds + b * SHM_K, qr, r32, hi, kcol0, cinit);
        partialSM<MODE>(p0, p1, ccls == 1, lut, j * 64, qpos, hi, shc);
        finishSM(p0, p1, l_reg, pa0, pa1, pa2, pa3);
        SBAR();
        pv_d0_pf(o, vb0 + b * SHM_V, pa0, pa1, pa2, pa3);
        SBAR();
        if (j + 1 < NT) { asm volatile("s_waitcnt vmcnt(0)" ::: "memory"); SWRITE(b ^ 1); }
        __syncthreads();
    }
    if (hi == 0) li_l[r32] = l_reg; asm volatile("s_waitcnt lgkmcnt(0)" ::: "memory");
    float rli[16];
#pragma unroll
    for (int r = 0; r < 16; ++r) rli[r] = __builtin_amdgcn_rcpf(li_l[crow(r, hi)]);
    bf16_t* Ow = Ob + (long)wrow * C::LDO;
    if (MODE == 0) {
#pragma unroll
        for (int r = 0; r < 16; ++r) { const int orow = crow(r, hi);
#pragma unroll
            for (int d0 = 0; d0 < 4; ++d0) Ow[(long)orow * C::LDO + d0 * 32 + r32] = (bf16_t)(cvtpk(o[d0][r] * rli[r], 0.f) & 0xffffu); }
    } else {
        float* X = (float*)lds + (wid & 3) * 4096 + lane;
        if (wid >= 4) {
#pragma unroll
            for (int d0 = 0; d0 < 4; ++d0)
#pragma unroll
                for (int r = 0; r < 16; ++r) X[(d0 * 16 + r) * 64] = o[d0][r] * rli[r];
        }
        __syncthreads();
        if (wid < 4) {
            float ss[16];
#pragma unroll
            for (int r = 0; r < 16; ++r) ss[r] = 0.f;
#pragma unroll
            for (int d0 = 0; d0 < 4; ++d0)
#pragma unroll
                for (int r = 0; r < 16; ++r) { const float v = o[d0][r] * rli[r] - lam * X[(d0 * 16 + r) * 64]; o[d0][r] = v; ss[r] += v * v; }
#pragma unroll
            for (int r = 0; r < 16; ++r) { float s = ss[r]; s += __shfl_xor(s, 1); s += __shfl_xor(s, 2); s += __shfl_xor(s, 4); s += __shfl_xor(s, 8); s += __shfl_xor(s, 16);
                ss[r] = rsqrtf(s * (1.f / 128.f) + EPS) * 0.8f; }
#pragma unroll
            for (int d0 = 0; d0 < 4; ++d0) { const float gsv = gsub[d0 * 32 + r32];
#pragma unroll
                for (int r = 0; r < 16; ++r) Ow[(long)crow(r, hi) * C::LDO + d0 * 32 + r32] = (bf16_t)(cvtpk(o[d0][r] * ss[r] * gsv, 0.f) & 0xffffu); }
        }
        __syncthreads();
    }
#undef SLOAD
#undef SWRITE
#undef SETC
}
template <int MODE>
__device__ __forceinline__ void attn_unit_st(const bf16_t* Qb, const bf16_t* Kh, const bf16_t* Vh, bf16_t* Ob, int seq, int qpos0, float lam, const float* gsub, char* lds, float* wscr, const float* lut, float bound) {
    using C = Cfg<MODE>;
    constexpr int SHM_V = 64 * 128 * 2, SHM_K = 64 * C::KROWB, NQ = C::DQK / 16, NKS = C::NKS;
    int tid_ = threadIdx.x; asm volatile("" : "+v"(tid_));
    const int tid = tid_, wid = __builtin_amdgcn_readfirstlane(tid >> 6), lane = tid & 63, r32 = lane & 31, hi = lane >> 5;
    char* V_lds = lds; char* K_lds = lds + 2 * SHM_V;
    float* li_l = wscr + wid * 64;
    const int wrow = MODE ? (wid & 3) * 32 : wid * 32, kcol0 = MODE ? (wid >> 2) * 128 : 0;
    const int qlo = qpos0 + wrow, qpos = qlo + r32;
    float l_reg = 0; f32x16 o[4] = {}; bf16x8 qr[NQ]; f32x16 cinit; int ccls = -2; float shc = 0.f;
#define SETC(k0_) do { const int c_ = MODE ? tile_cls((k0_), qlo) : 0; if (c_ != ccls) { const float v_ = (MODE ? (c_ == 0 ? lut[0] : (c_ == 2 ? lut[256] : 0.f)) : 0.f) - bound; \
    _Pragma("unroll") for (int r_ = 0; r_ < 16; ++r_) cinit[r_] = v_; shc = v_; ccls = c_; } } while (0)
    const bf16_t* Qw = Qb + (long)(wrow + r32) * C::LDQ + (MODE ? (wid >> 2) * 64 : 0) + hi * 8;
#pragma unroll
    for (int d0 = 0; d0 < NQ; ++d0) qr[d0] = *reinterpret_cast<const bf16x8*>(Qw + d0 * 16);
    const int sr = tid >> 4, sc = (tid & 15) * 8, vst0 = v_st(sr, sc), vst1 = v_st(32 + sr, sc);
    int krow[NKS], kch[NKS];
#pragma unroll
    for (int i = 0; i < NKS; ++i) { if (MODE == 0) { const int id = tid + 512 * i; krow[i] = id / 24; kch[i] = id % 24; } else { krow[i] = sr + 32 * i; kch[i] = tid & 15; } }
    const int vb0 = (int)(uintptr_t)V_lds + v_rd_base(lane);
    bf16x8 vs0, vs1, ks[NKS];
#define SLOAD(k0) do { vs0 = *(const bf16x8*)(&Vh[(long)((k0) + sr) * C::LDV + sc]); vs1 = *(const bf16x8*)(&Vh[(long)((k0) + 32 + sr) * C::LDV + sc]); \
    _Pragma("unroll") for (int q_ = 0; q_ < NKS; ++q_) ks[q_] = *(const bf16x8*)(&Kh[(long)((k0) + krow[q_]) * C::LDK + kch[q_] * 8]); } while (0)
#define SWRITE(b) do { *(bf16x8*)(V_lds + (b) * SHM_V + vst0) = vs0; *(bf16x8*)(V_lds + (b) * SHM_V + vst1) = vs1; \
    _Pragma("unroll") for (int q_ = 0; q_ < NKS; ++q_) *(bf16x8*)(K_lds + (b) * SHM_K + krow[q_] * C::KROWB + kch[q_] * 16) = ks[q_]; } while (0)
    f32x16 p0, p1; bf16x8 pa0, pa1, pa2, pa3; const int NT = seq / 64;
    const bool grpB = wid >= 4;
#define LBAR() do { asm volatile("s_waitcnt lgkmcnt(0)" ::: "memory"); __builtin_amdgcn_s_barrier(); asm volatile("" ::: "memory"); } while (0)
    SLOAD(0); asm volatile("s_waitcnt vmcnt(0)" ::: "memory"); SWRITE(0); if (1 < NT) SLOAD(64); LBAR();
    if (grpB) LBAR();
#pragma unroll 1
    for (int j = 0; j < NT; ++j) {
        const int b = j & 1;
        SBAR();
        SETC(j * 64); qkt<MODE>(p0, p1, K_lds + b * SHM_K, qr, r32, hi, kcol0, cinit); partialSM<MODE>(p0, p1, ccls == 1, lut, j * 64, qpos, hi, shc); finishSM(p0, p1, l_reg, pa0, pa1, pa2, pa3);
        SBAR();
        if (grpB && j + 1 < NT) { SWRITE(b ^ 1); if (j + 2 < NT) SLOAD((j + 2) * 64); }
        LBAR();
        pv_d0(o, vb0 + b * SHM_V, pa0, pa1, pa2, pa3);
        SBAR();
        if (!grpB && j + 1 < NT) { SWRITE(b ^ 1); if (j + 2 < NT) SLOAD((j + 2) * 64); }
        LBAR();
    }
    if (!grpB) LBAR();
    __syncthreads();
#undef LBAR
    if (hi == 0) li_l[r32] = l_reg; asm volatile("s_waitcnt lgkmcnt(0)" ::: "memory");
    float rli[16];
#pragma unroll
    for (int r = 0; r < 16; ++r) rli[r] = __builtin_amdgcn_rcpf(li_l[crow(r, hi)]);
    bf16_t* Ow = Ob + (long)wrow * C::LDO;
    if (MODE == 0) {
#pragma unroll
        for (int r = 0; r < 16; ++r) { const int orow = crow(r, hi);
#pragma unroll
            for (int d0 = 0; d0 < 4; ++d0) Ow[(long)orow * C::LDO + d0 * 32 + r32] = (bf16_t)(cvtpk(o[d0][r] * rli[r], 0.f) & 0xffffu); }
    } else {
        float* X = (float*)lds + (wid & 3) * 4096 + lane;
        if (wid >= 4) {
#pragma unroll
            for (int d0 = 0; d0 < 4; ++d0)
#pragma unroll
                for (int r = 0; r < 16; ++r) X[(d0 * 16 + r) * 64] = o[d0][r] * rli[r];
        }
        __syncthreads();
        if (wid < 4) {
            float ss[16];
#pragma unroll
            for (int r = 0; r < 16; ++r) ss[r] = 0.f;
#pragma unroll
            for (int d0 = 0; d0 < 4; ++d0)
#pragma unroll
                for (int r = 0; r < 16; ++r) { const float v = o[d0][r] * rli[r] - lam * X[(d0 * 16 + r) * 64]; o[d0][r] = v; ss[r] += v * v; }
#pragma unroll
            for (int r = 0; r < 16; ++r) { float s = ss[r]; s += __shfl_xor(s, 1); s += __shfl_xor(s, 2); s += __shfl_xor(s, 4); s += __shfl_xor(s, 8); s += __shfl_xor(s, 16);
                ss[r] = rsqrtf(s * (1.f / 128.f) + EPS) * 0.8f; }
#pragma unroll
            for (int d0 = 0; d0 < 4; ++d0) { const float gsv = gsub[d0 * 32 + r32];
#pragma unroll
                for (int r = 0; r < 16; ++r) Ow[(long)crow(r, hi) * C::LDO + d0 * 32 + r32] = (bf16_t)(cvtpk(o[d0][r] * ss[r] * gsv, 0.f) & 0xffffu); }
        }
        __syncthreads();
    }
#undef SLOAD
#undef SWRITE
#undef SETC
}
}

__device__ __forceinline__ float wave_sum(float v) {
#pragma unroll
    for (int o = 1; o < 64; o <<= 1) v += __shfl_xor(v, o);
    return v;
}
__device__ __forceinline__ void transpose_item(const float* W, int ldw, int srccol, const float* g, bf16_t* WT, int K, int dstrow, int k0, LAS float* scr, int lane) {
    if (srccol < 0) {
        const int c = lane & 7;
#pragma unroll
        for (int j = 0; j < 4; ++j) { const int n = (lane >> 3) + 8 * j; *(u32x4*)(WT + (size_t)(dstrow + n) * K + k0 + 8 * c) = (u32x4){0u, 0u, 0u, 0u}; }
        return;
    }
    {
        const int kr = lane >> 3, nq = lane & 7; f32x4 v[8];
#pragma unroll
        for (int i = 0; i < 8; ++i) v[i] = *(const f32x4*)(W + (size_t)(k0 + 8 * i + kr) * ldw + srccol + 4 * nq);
#pragma unroll
        for (int i = 0; i < 8; ++i) { const int kk = 8 * i + kr; f32x4 x = v[i]; if (g) x = x * g[k0 + kk]; LAS float* d = scr + kk * 33 + 4 * nq; d[0] = x[0]; d[1] = x[1]; d[2] = x[2]; d[3] = x[3]; }
    }
    asm volatile("s_waitcnt lgkmcnt(0)" ::: "memory");
    const int c = lane & 7;
#pragma unroll
    for (int j = 0; j < 4; ++j) { const int n = (lane >> 3) + 8 * j; const LAS float* s = scr + (8 * c) * 33 + n;
        u32x4 o; o.x = cvtpk(s[0 * 33], s[1 * 33]); o.y = cvtpk(s[2 * 33], s[3 * 33]); o.z = cvtpk(s[4 * 33], s[5 * 33]); o.w = cvtpk(s[6 * 33], s[7 * 33]);
        *(u32x4*)(WT + (size_t)(dstrow + n) * K + k0 + 8 * c) = o; }
    asm volatile("s_waitcnt lgkmcnt(0)" ::: "memory");
}

#define XB_TMO      128
#define XB_XCNT(j)  (256  + 64 * (j))
#define XB_XSUB(j)  (1280 + 64 * (j))
#define XB_XGEN(j)  (2304 + 64 * (j))
#define XB_TOP      3328
#define XB_TOPGEN   3392
#define XCD_BAR_WORDS 3456
#define XB_SPIN_CAP (1u << 18)

__device__ __forceinline__ unsigned xb_ld(unsigned* p)              { return __hip_atomic_load(p, __ATOMIC_RELAXED, __HIP_MEMORY_SCOPE_AGENT); }
__device__ __forceinline__ unsigned xb_add(unsigned* p, unsigned v) { return __hip_atomic_fetch_add(p, v, __ATOMIC_RELAXED, __HIP_MEMORY_SCOPE_AGENT); }
__device__ __forceinline__ unsigned xb_xcc_id() { return (unsigned)__builtin_amdgcn_s_getreg((3 << 11) | 20) & 0xFu; }
#define XB_SPIN(cond, bar) do { unsigned _sp = 0; while (cond) { __builtin_amdgcn_s_sleep(1); \
    if ((++_sp & 255u) == 0u) { if (xb_ld(&(bar)[XB_TMO])) break; if (_sp > XB_SPIN_CAP) { atomicAdd(&(bar)[XB_TMO], 1u); break; } } } } while (0)

struct XcdBarrier {
    unsigned* bar; unsigned x;
    volatile LAS unsigned* st;
};

__device__ __forceinline__ XcdBarrier xcd_barrier_post(unsigned* bar, volatile LAS unsigned* st) {
    XcdBarrier b; b.bar = bar; b.x = xb_xcc_id(); b.st = st;
    if (threadIdx.x == 0) (void)xb_add(&bar[XB_XCNT(b.x)], 1u);
    return b;
}
__device__ __forceinline__ void xcd_barrier_complete(unsigned* bar, unsigned x, unsigned& nloc, unsigned& nx) {
    const unsigned G = gridDim.x * gridDim.y * gridDim.z;
    unsigned sum, cnt, mine, sp = 0u;
    for (;;) {
        sum = 0u; cnt = 0u; mine = 0u;
#pragma unroll
        for (unsigned j = 0; j < 16; ++j) { const unsigned c = xb_ld(&bar[XB_XCNT(j)]); sum += c; cnt += (c > 0u) ? 1u : 0u; mine = (j == x) ? c : mine; }
        if (sum == G) break;
        __builtin_amdgcn_s_sleep(1);
        if ((++sp & 255u) == 0u) { if (xb_ld(&bar[XB_TMO])) break; if (sp > XB_SPIN_CAP) { atomicAdd(&bar[XB_TMO], 1u); break; } }
    }
    nloc = mine > 0u ? mine : 1u; nx = cnt > 0u ? cnt : 1u;
}

__device__ __forceinline__ void xcd_barrier(const XcdBarrier& b) {
    asm volatile("s_waitcnt vmcnt(0)" ::: "memory");
    __syncthreads();
    if (threadIdx.x == 0) {
        unsigned* bar = b.bar;
        __builtin_amdgcn_s_waitcnt(0);
        unsigned nloc = b.st[0], nx = b.st[1];
        if (nloc == 0u) { xcd_barrier_complete(bar, b.x, nloc, nx); b.st[0] = nloc; b.st[1] = nx; }
        const unsigned old = xb_add(&bar[XB_XSUB(b.x)], 1u);
        const unsigned gen = old / nloc;
        if (old + 1u == (gen + 1u) * nloc) {
            __builtin_amdgcn_fence(__ATOMIC_RELEASE, "agent");
            asm volatile("s_waitcnt vmcnt(0)" ::: "memory");
            const unsigned og = xb_add(&bar[XB_TOP], 1u);
            const unsigned tg = og / nx;
            if (og + 1u == (tg + 1u) * nx) xb_add(&bar[XB_TOPGEN], 1u);
            else XB_SPIN(xb_ld(&bar[XB_TOPGEN]) == tg, bar);
            __builtin_amdgcn_fence(__ATOMIC_ACQUIRE, "agent");
            xb_add(&bar[XB_XGEN(b.x)], 1u);
            asm volatile("s_waitcnt vmcnt(0)" ::: "memory");
        } else {
            XB_SPIN(xb_ld(&bar[XB_XGEN(b.x)]) == gen, bar);
            __builtin_amdgcn_fence(__ATOMIC_ACQUIRE, "agent");
            asm volatile("s_waitcnt vmcnt(0)" ::: "memory");
        }
    }
    __syncthreads();
}


struct Args { const float* in[25]; float* out; unsigned char* ws; int ph_lo, ph_hi; };

#define DECL_PTRS \
    unsigned char* ws = args.ws; unsigned char* dout = (unsigned char*)args.out; const float* xp = args.in[0]; const float* xs = args.in[1]; \
    float* ssq = (float*)(ws + WS_SSQ); float* sskv = (float*)(ws + WS_SSKV); float* sspe = (float*)(ws + WS_SSPE); float* ss2 = (float*)(ws + WS_SS2); \
    float* lutg = (float*)(ws + WS_LUT); float* lamp = (float*)(ws + WS_LAM); f32x2* rope = (f32x2*)(ws + WS_ROPE); \
    bf16_t* WIN1 = (bf16_t*)(ws + WS_WIN1); bf16_t* CQ = (bf16_t*)(ws + WS_CQ); bf16_t* CKV = (bf16_t*)(ws + WS_CKV); bf16_t* OA = (bf16_t*)(ws + WS_OA); \
    float* KPE = (float*)(ws + WS_KPE); bf16_t* WG = (bf16_t*)(ws + WS_WG); bf16_t* WQB = (bf16_t*)(ws + WS_WQB); bf16_t* WKVB = (bf16_t*)(ws + WS_WKVB); \
    bf16_t* WUPM = (bf16_t*)(ws + WS_WUPM); bf16_t* WUPD = (bf16_t*)(ws + WS_WUPD); bf16_t* WOT = (bf16_t*)(ws + WS_WO); bf16_t* WGU = (bf16_t*)(ws + WS_WGU); bf16_t* WDN = (bf16_t*)(ws + WS_WDN); \
    bf16_t* H = (bf16_t*)(ws + WS_H); bf16_t* QD = (bf16_t*)(ws + WS_QD); bf16_t* KD = (bf16_t*)(ws + WS_KD); bf16_t* VD = (bf16_t*)(ws + WS_VD); \
    bf16_t* MG = (bf16_t*)(ws + WS_MERGED); bf16_t* ACT = (bf16_t*)(ws + WS_ACT); \
    bf16_t* QM = (bf16_t*)(dout + DO_QM); bf16_t* KM = (bf16_t*)(dout + DO_KM); bf16_t* VM = (bf16_t*)(dout + DO_VM); bf16_t* SG = (bf16_t*)dout; \
    (void)0
__global__ void __launch_bounds__(512) mk_fwd(Args args) {
    extern __shared__ __attribute__((aligned(16))) unsigned char lds[];
    LAS unsigned char* ldsl = (LAS unsigned char*)lds;
    const int tid = threadIdx.x, lane = tid & 63, wave = __builtin_amdgcn_readfirstlane(tid >> 6);
    const int G = gridDim.x, bx = blockIdx.x;
    const int lo = args.ph_lo, hi_ = args.ph_hi;
#ifndef PH_MASK
#define PH_MASK 0xFFFF
#endif
#define IN(k) (((PH_MASK >> (k)) & 1) && lo <= (k) && (k) < hi_)
#if MK_XCD_BARRIER
    if (lo > 1000) cg::this_grid().sync();
    { volatile LAS unsigned* st_ = (volatile LAS unsigned*)(ldsl + LDS_XB); if (tid < 2) st_[tid] = 0u; __syncthreads(); }
    XcdBarrier xbar; xbar.bar = (unsigned*)(args.ws + WS_BAR); xbar.x = 0; xbar.st = nullptr;
    if (hi_ - lo > 1) xbar = xcd_barrier_post((unsigned*)(args.ws + WS_BAR), (volatile LAS unsigned*)(ldsl + LDS_XB));
#define SEAM(k) do { if (IN(k) && IN((k) + 1)) { xcd_barrier(xbar); } } while (0)
#else
#define SEAM(k) do { if (IN(k) && IN((k) + 1)) { cg::this_grid().sync(); } } while (0)
#endif
    LAS float* red = (LAS float*)(ldsl + LDS_RED);

    if (IN(0)) { DECL_PTRS;
        LAS float* scr = (LAS float*)(ldsl + wave * 16384);
        const int gw = bx * 8 + wave, NGW = G * 8;
        constexpr int I_IN1 = 128 * 32, I_G = 128 * 32, I_QB = 64 * 8, I_KVB = 64 * 4, I_UPM = 64 * 16, I_UPD = 64 * 16, I_O = 64 * 32, I_GU = 352 * 32, I_DN = 64 * 88;
        constexpr int NITEMS = I_IN1 + I_G + I_QB + I_KVB + I_UPM + I_UPD + I_O + I_GU + I_DN;
        for (int it = gw; it < NITEMS; it += NGW) {
            int r = it;
            if (r < I_IN1) { const int b = r / 32, kb = r % 32, pn = b >> 3, pb = b & 7, bj = pb >> 2, wc = pb & 3; int src;
                if (pn < 2) src = pn * 256 + 32 * pb; else if (pn == 2) src = 512 + 32 * pb; else if (pn == 3) src = (wc == 0) ? 768 + 32 * bj : -1;
                else if (pn < 8) src = 832 + (pn - 4) * 256 + 64 * wc + 32 * bj; else if (pn < 12) src = 1856 + (pn - 8) * 256 + 64 * wc + 32 * bj; else src = 2880 + (pn - 12) * 256 + 32 * pb;
                transpose_item(args.in[3], 8000, src, args.in[2], WIN1, 2048, 32 * b, 64 * kb, scr, lane); continue; } r -= I_IN1;
            if (r < I_G) { const int b = r / 32, kb = r % 32; transpose_item(args.in[3], 8000, 3904 + 32 * b, args.in[2], WG, 2048, 32 * b, 64 * kb, scr, lane); continue; } r -= I_G;
            if (r < I_QB) { const int b = r / 8, kb = r % 8, h = b >> 3, pb = b & 7, bj = pb >> 2, wc = pb & 3; const int src = (wc < 3) ? h * 192 + 64 * wc + 32 * bj : -1;
                transpose_item(args.in[5], 1536, src, args.in[4], WQB, 512, 32 * b, 64 * kb, scr, lane); continue; } r -= I_QB;
            if (r < I_KVB) { const int b = r / 4, kb = r % 4; transpose_item(args.in[7], 2048, 32 * b, args.in[6], WKVB, 256, 32 * b, 64 * kb, scr, lane); continue; } r -= I_KVB;
            if (r < I_UPM) { const int b = r / 16, kb = r % 16; transpose_item(args.in[17], 2048, 32 * b, nullptr, WUPM, 1024, 32 * b, 64 * kb, scr, lane); continue; } r -= I_UPM;
            if (r < I_UPD) { const int b = r / 16, kb = r % 16; transpose_item(args.in[18], 2048, 32 * b, nullptr, WUPD, 1024, 32 * b, 64 * kb, scr, lane); continue; } r -= I_UPD;
            if (r < I_O) { const int b = r / 32, kb = r % 32; transpose_item(args.in[19], 2048, 32 * b, nullptr, WOT, 2048, 32 * b, 64 * kb, scr, lane); continue; } r -= I_O;
            if (r < I_GU) { const int b = r / 32, kb = r % 32, pn = b >> 3, pb = b & 7, bj = pb >> 2, wc = pb & 3;
                transpose_item(bj ? args.in[22] : args.in[21], DFF, 128 * pn + 32 * wc, args.in[20], WGU, 2048, 32 * b, 64 * kb, scr, lane); continue; } r -= I_GU;
            { const int b = r / 88, kb = r % 88; transpose_item(args.in[23], 2048, 32 * b, nullptr, WDN, DFF, 32 * b, 64 * kb, scr, lane); }
        }
        for (int m = gw; m < T; m += NGW) {
            const float* xrow = m < TP ? xp + (size_t)m * DM : xs + (size_t)(m - TP) * DM;
            const f32x4* xr = (const f32x4*)xrow + lane; f32x4 v[8]; float s = 0.f;
#pragma unroll
            for (int j = 0; j < 8; ++j) { v[j] = xr[64 * j]; s += dot4(v[j]); }
            const float rstd = rsqrtf(wave_sum(s) * (1.f / DM) + EPS);
            u32x2* o8 = (u32x2*)(H + (size_t)m * DM) + lane;
#pragma unroll
            for (int j = 0; j < 8; ++j) { u32x2 w; w.x = cvtpk(v[j][0] * rstd, v[j][1] * rstd); w.y = cvtpk(v[j][2] * rstd, v[j][3] * rstd); o8[64 * j] = w; }
        }
        for (int i = bx * 512 + tid; i < TP * 32; i += G * 512) { const int pos = i >> 5, k = i & 31; const float inv = powf(10000.f, -(float)k / 32.f); const float ang = (float)pos * inv;
            double sn, cs; sincos((double)ang, &sn, &cs); rope[i] = (f32x2){(float)cs, (float)sn}; }
        for (int i = bx * 512 + tid; i < T; i += G * 512) { ssq[i] = 0.f; sskv[i] = 0.f; ss2[i] = 0.f; }
        if (bx == 0) {
            for (int i = tid; i < 8 * 257; i += 512) { const int h = i / 257, rel = i % 257 - 128; const int n = rel < 0 ? -rel : rel; int bk;
                if (n < 8) bk = n; else { int lg = 8 + (int)(log((double)n / 8.0) / log(16.0) * 8.0); bk = lg < 15 ? lg : 15; }
                if (rel > 0) bk += 16; lutg[h * 260 + i % 257] = args.in[24][bk * 8 + h] * LOG2E; }
            if (wave == 0) { const float a = wave_sum(args.in[12][lane] * args.in[13][lane]), b = wave_sum(args.in[14][lane] * args.in[15][lane]);
                if (lane == 0) lamp[0] = expf(a) - expf(b) + 0.2f; }
            if (wave == 1) { float mq = fabsf(args.in[10][lane]), mk = fabsf(args.in[11][lane]), mb = 0.f, nq = 0.f, nk = 0.f;
                for (int i = lane; i < 256; i += 64) mb = fmaxf(mb, fabsf(args.in[24][i])); for (int i = lane; i < 192; i += 64) { nq = fmaxf(nq, fabsf(args.in[8][i])); nk = fmaxf(nk, fabsf(args.in[9][i])); }
                for (int o = 1; o < 64; o <<= 1) { mq = fmaxf(mq, __shfl_xor(mq, o)); mk = fmaxf(mk, __shfl_xor(mk, o)); mb = fmaxf(mb, __shfl_xor(mb, o)); nq = fmaxf(nq, __shfl_xor(nq, o)); nk = fmaxf(nk, __shfl_xor(nk, o)); }
                if (lane == 0) { lamp[1] = 64.f * mq * mk * SC_DIFF + mb * LOG2E; lamp[2] = 192.f * nq * nk * SC_MLA; } }
        }
    }
    SEAM(0);
    if (IN(1)) { DECL_PTRS;
        pg8::Gemm g{H, H, WIN1, WIN1, 2048}; pg8::StaticOrder S; S.init(T, 4096, G, bx);
        Epi1 E{CQ, CKV, QD, KD, VD, KPE, ssq, sskv, sspe, args.in[10], args.in[11]};
        pg8::gemm_phase(ldsl, g, S, E);
    }
    SEAM(1);
    if (IN(2)) { DECL_PTRS;
#ifndef P2_SKIPA
        { pg8::Gemm g{CQ, CQ, WQB, WQB, 512}; pg8::StaticOrder S; S.init(T, 2048, G, bx); Epi2a E{QM, ssq, args.in[8], rope, red}; pg8::gemm_phase(ldsl, g, S, E); }
#endif
#ifndef P2_SKIPB
        { pg8::Gemm g{CKV, CKV, WKVB, WKVB, 256}; pg8::StaticOrder S; S.init(T, 2048, G, bx); Epi2b E{KM, VM, sskv, sspe, KPE, args.in[9], rope, red}; pg8::gemm_phase(ldsl, g, S, E); }
#endif
    }
    SEAM(2);
    if (IN(3)) { DECL_PTRS;
        float* wscr = (float*)(lds + LDS_WSCR); float* lut = (float*)(lds + LDS_LUT); const float bnd1 = lamp[1], bnd0 = lamp[2];
#ifndef ATT_SKIP0
        for (int rep_ = 0; rep_ < 1 + PROBE_MLA; ++rep_) {
        for (int u = bx; u < 512; u += G) { const int h = u & 7, qb = u >> 3; const size_t r0 = (size_t)qb * 256;
            att::ATTN_FN0<0>(QM + r0 * 1536 + h * 192, KM + h * 192, VM + h * 128, OA + r0 * 1024 + h * 128, TP, 0, 0.f, nullptr, (char*)lds, wscr, lut, bnd0); }
        for (int u = bx; u < 512; u += G) { const int h = u & 7, idx = u >> 3, b = idx >> 3, qb = idx & 7; const size_t s0 = (size_t)TP + (size_t)b * SSEQ, r0 = s0 + (size_t)qb * 256;
            att::ATTN_FN0<0>(QM + r0 * 1536 + h * 192, KM + s0 * 1536 + h * 192, VM + s0 * 1024 + h * 128, OA + r0 * 1024 + h * 128, SSEQ, 0, 0.f, nullptr, (char*)lds, wscr, lut, bnd0); }
        }
#endif
#ifndef ATT_SKIP1
        const float lam = lamp[0]; const float* gsub = args.in[16];
        int curh = -1;
        for (int u = bx; u < 1024; u += G) { const int h = u & 7, qb = u >> 3; const size_t r0 = (size_t)qb * 128;
            if (h != curh) { __syncthreads(); for (int i = tid; i < 257; i += 512) lut[i] = lutg[h * 260 + i]; __syncthreads(); curh = h; }
            att::ATTN_FN1<1>(QD + r0 * 1024 + h * 128, KD + h * 128, VD + h * 128, QD + r0 * 1024 + h * 128, TP, qb * 128, lam, gsub, (char*)lds, wscr, lut, bnd1); }
        for (int u = bx; u < 1024; u += G) { const int h = u & 7, idx = u >> 3, b = idx >> 4, qb = idx & 15; const size_t s0 = (size_t)TP + (size_t)b * SSEQ, r0 = s0 + (size_t)qb * 128;
            if (h != curh) { __syncthreads(); for (int i = tid; i < 257; i += 512) lut[i] = lutg[h * 260 + i]; __syncthreads(); curh = h; }
            att::ATTN_FN1<1>(QD + r0 * 1024 + h * 128, KD + s0 * 1024 + h * 128, VD + s0 * 1024 + h * 128, QD + r0 * 1024 + h * 128, SSEQ, qb * 128, lam, gsub, (char*)lds, wscr, lut, bnd1); }
#endif
    }
    SEAM(3);
    if (IN(4)) { DECL_PTRS; for (int rep_ = 0; rep_ < 1 + PROBE_P4; ++rep_) { pg8::Gemm g{H, H, WG, WG, 2048}; pg8::StaticOrder S; S.init(T, 4096, G, bx); Epi4 E{SG}; pg8::gemm_phase(ldsl, g, S, E); } }
    SEAM(4);
    if (IN(5)) { DECL_PTRS; pg8::Gemm g{OA, QD, WUPM, WUPD, 1024}; pg8::StaticOrder S; S.init(T, 2048, G, bx, 2); Epi5 E{SG, MG}; pg8::gemm_phase(ldsl, g, S, E); }
    SEAM(5);
    if (IN(6)) { DECL_PTRS; pg8::Gemm g{MG, MG, WOT, WOT, 2048}; pg8::StaticOrder S; S.init(T, 2048, G, bx); Epi6 E{xp, xs, args.out, H, ss2}; pg8::gemm_phase(ldsl, g, S, E); }
    SEAM(6);
#pragma unroll 1
    for (int c = 0; c < NCHUNK; ++c) {
        if (IN(7 + 2 * c)) { DECL_PTRS; const bf16_t* A = H + (size_t)c * TC * DM; pg8::Gemm g{A, A, WGU, WGU, 2048}; pg8::StaticOrder S; S.init(TC, 2 * DFF, G, bx); Epi7 E{ACT, ss2, c * TC}; pg8::gemm_phase(ldsl, g, S, E); }
        SEAM(7 + 2 * c);
        if (IN(8 + 2 * c)) { DECL_PTRS; pg8::Gemm g{ACT, ACT, WDN, WDN, DFF}; pg8::StaticOrder S; S.init(TC, 2048, G, bx); Epi8 E{args.out, H, c * TC}; pg8::gemm_phase(ldsl, g, S, E); }
        if (c + 1 < NCHUNK) SEAM(8 + 2 * c);
    }
#undef IN
#undef SEAM
}


#ifdef MK_DEBUG
__device__ __forceinline__ float blk_sum(float v, float* sh) {
    v = wave_sum(v); __syncthreads(); if ((threadIdx.x & 63) == 0) sh[threadIdx.x >> 6] = v; __syncthreads();
    float t = 0.f; for (int i = 0; i < 8; ++i) t += sh[i]; __syncthreads(); return t; }
__device__ __forceinline__ float blk_max(float v, float* sh) {
    for (int o = 1; o < 64; o <<= 1) v = fmaxf(v, __shfl_xor(v, o)); __syncthreads(); if ((threadIdx.x & 63) == 0) sh[threadIdx.x >> 6] = v; __syncthreads();
    float t = sh[0]; for (int i = 1; i < 8; ++i) t = fmaxf(t, sh[i]); __syncthreads(); return t; }
__device__ __forceinline__ int chk_row(int s, int lo, int n) {
    const int sp[10] = {0, 127, 128, 255, 256, 16383, 16384, 16384 + 2047, 16384 + 2048, 32767};
    int r = (s < 10) ? sp[s] : (int)(((unsigned)s * 2654435761u >> 7) % (unsigned)T);
    if (r < lo || r >= lo + n) r = lo + (int)(((unsigned)s * 2246822519u >> 9) % (unsigned)n);
    return r; }
__global__ void __launch_bounds__(512) chk(Args args, int stage, int chunk) {
    extern __shared__ __attribute__((aligned(16))) unsigned char lds[];
    DECL_PTRS;
    float* sh = (float*)lds; float* big = (float*)(lds + 1024);
    unsigned* flags = (unsigned*)(ws + WS_LAM + 256); float* qsave = (float*)(ws + WS_LAM + 4096); float* x1save = (float*)(ws + WS_LAM + 4096 + 128 * 128 * 4);
    const int s = blockIdx.x, tid = threadIdx.x;
    const float* w_in = args.in[3];
    float num = 0.f, den = 0.f;
    if (stage == 1) {
        const int row = chk_row(s, 0, T), grp = (s * 7 + 3) % 48;
        const float* xr = row < TP ? xp + (size_t)row * DM : xs + (size_t)(row - TP) * DM;
        float ssx = 0.f; for (int k = tid; k < DM; k += 512) ssx += xr[k] * xr[k]; const float rstd = rsqrtf(blk_sum(ssx, sh) / DM + EPS);
        const int kind = grp / 16, gi = grp % 16, l = tid & 63, part = tid >> 6;
        const int col = 832 + kind * 1024 + gi * 64 + l; float z = 0.f;
        for (int k = part; k < DM; k += 8) z += xr[k] * rstd * args.in[2][k] * w_in[(size_t)k * 8000 + col];
        big[part * 64 + l] = z; __syncthreads();
        float zz = 0.f; if (tid < 64) { for (int p = 0; p < 8; ++p) zz += big[p * 64 + tid]; }
        float val = zz, got = 0.f;
        if (tid < 64) {
            if (kind < 2) { const float ss = wave_sum(zz * zz); const float rs = rsqrtf(ss / 64.f + EPS); val = zz * rs * (kind == 0 ? args.in[10][tid] * SC_DIFF : args.in[11][tid]); }
            const bf16_t* base = kind == 0 ? QD : (kind == 1 ? KD : VD); got = bf2f(base[(size_t)row * 1024 + gi * 64 + tid]);
            num = (got - val) * (got - val); den = val * val; }
        const int row2 = chk_row(s, 0, T), h2 = s & 7; if (tid < 128) qsave[s * 128 + tid] = bf2f(QD[(size_t)row2 * 1024 + h2 * 128 + tid]);
    } else if (stage == 2) {
        const int row = chk_row(s, 0, T), h = s & 7; const int s0 = row < TP ? 0 : TP + ((row - TP) / SSEQ) * SSEQ, seq = row < TP ? TP : SSEQ, pos = row - s0;
        float* sc0 = big; float* sc1 = big + 16384;
        const float* q = qsave + s * 128; float mx0 = -1e30f, mx1 = -1e30f;
        for (int k = tid; k < seq; k += 512) { const bf16_t* kr = KD + (size_t)(s0 + k) * 1024 + h * 128; float a = 0.f, b = 0.f;
            for (int d = 0; d < 64; ++d) { a += q[d] * bf2f(kr[d]); b += q[64 + d] * bf2f(kr[64 + d]); }
            const int rel = k - pos, n = rel < 0 ? -rel : rel; int bk; if (n < 8) bk = n; else { int lg = 8 + (int)(logf((float)n / 8.f) / logf(16.f) * 8.f); bk = lg < 15 ? lg : 15; } if (rel > 0) bk += 16;
            const float bias = args.in[24][bk * 8 + h] * LOG2E; a += bias; b += bias; sc0[k] = a; sc1[k] = b; mx0 = fmaxf(mx0, a); mx1 = fmaxf(mx1, b); }
        mx0 = blk_max(mx0, sh); mx1 = blk_max(mx1, sh); float l0 = 0.f, l1 = 0.f;
        for (int k = tid; k < seq; k += 512) { const float a = exp2f(sc0[k] - mx0), b = exp2f(sc1[k] - mx1); sc0[k] = a; sc1[k] = b; l0 += a; l1 += b; }
        l0 = blk_sum(l0, sh); l1 = blk_sum(l1, sh);
        const int dv = tid & 127, sl = tid >> 7; float o0 = 0.f, o1 = 0.f;
        for (int k = sl; k < seq; k += 4) { const float v = bf2f(VD[(size_t)(s0 + k) * 1024 + h * 128 + dv]); o0 += sc0[k] * v; o1 += sc1[k] * v; }
        __syncthreads(); float* red2 = (float*)(lds + 1024 + 131072); red2[tid] = o0 / l0 - lamp[0] * (o1 / l1); __syncthreads();
        float o = 0.f; if (tid < 128) o = red2[tid] + red2[tid + 128] + red2[tid + 256] + red2[tid + 384];
        const float ms = blk_sum(tid < 128 ? o * o : 0.f, sh) / 128.f;
        if (tid < 128) { const float val = o * rsqrtf(ms + EPS) * args.in[16][tid] * 0.8f, got = bf2f(QD[(size_t)row * 1024 + h * 128 + tid]); num = (got - val) * (got - val); den = val * val; }
    } else if (stage == 3) {
        const int row = chk_row(s, 0, T), cb = ((s * 13 + 5) % 64) * 64;
        const float* xr = row < TP ? xp + (size_t)row * DM : xs + (size_t)(row - TP) * DM;
        float ssx = 0.f; for (int k = tid; k < DM; k += 512) ssx += xr[k] * xr[k]; const float rstd = rsqrtf(blk_sum(ssx, sh) / DM + EPS);
        const int l = tid & 63, part = tid >> 6; float z = 0.f;
        for (int k = part; k < DM; k += 8) z += xr[k] * rstd * args.in[2][k] * w_in[(size_t)k * 8000 + 3904 + cb + l];
        big[part * 64 + l] = z; __syncthreads();
        if (tid < 64) { float zz = 0.f; for (int p = 0; p < 8; ++p) zz += big[p * 64 + tid]; const float val = 1.f / (1.f + expf(-zz)), got = bf2f(SG[(size_t)row * 4096 + cb + tid]); num = (got - val) * (got - val); den = val * val; }
        { const float N3 = blk_sum(num, sh), D3 = blk_sum(den, sh); const float nb3 = blk_sum((tid < 64 && sqrtf(num) > 0.02f) ? 1.f : 0.f, sh);
          if (tid == 0 && s == DBG_S) { flags[20] = (unsigned)nb3; flags[21] = __float_as_uint(N3 / D3); }
          if (tid == 0 && !(N3 <= 1e-3f * D3)) { const int pm = row >> 8, pn = cb >> 8, gid = pm >> 3, fm = gid * 8, wgid = gid * 128 + pn * 8 + (pm - fm), xcd = wgid / 256, off = wgid % 256, L = off * 8 + xcd, ui = L / 256;
              atomicMax(flags + 16, (unsigned)(8 - ui)); atomicMax(flags + 17, (unsigned)(ui + 1)); atomicMax(flags + 18, (unsigned)(128 - s)); atomicMax(flags + 19, (unsigned)(s + 1)); } }
    } else if (stage == 4) {
        const int row = chk_row(s, 0, T), cb = ((s * 11 + 1) % 32) * 64; const int l = tid & 63, part = tid >> 6; float ua = 0.f, ub = 0.f;
        for (int j = part; j < 1024; j += 8) { ua += bf2f(OA[(size_t)row * 1024 + j]) * args.in[17][(size_t)j * 2048 + cb + l]; ub += bf2f(QD[(size_t)row * 1024 + j]) * args.in[18][(size_t)j * 2048 + cb + l]; }
        big[part * 64 + l] = ua; big[512 + part * 64 + l] = ub; __syncthreads();
        if (tid < 64) { float a = 0.f, b = 0.f; for (int p = 0; p < 8; ++p) { a += big[p * 64 + tid]; b += big[512 + p * 64 + tid]; }
            const float val = bf2f(SG[(size_t)row * 4096 + cb + tid]) * a + bf2f(SG[(size_t)row * 4096 + 2048 + cb + tid]) * b, got = bf2f(MG[(size_t)row * 2048 + cb + tid]); num = (got - val) * (got - val); den = val * val; }
    } else if (stage == 5) {
        const int row = chk_row(s, 0, T), cb = ((s * 5 + 2) % 32) * 64; const int l = tid & 63, part = tid >> 6; float u = 0.f;
        const float* xr = row < TP ? xp + (size_t)row * DM : xs + (size_t)(row - TP) * DM;
        for (int j = part; j < 2048; j += 8) u += bf2f(MG[(size_t)row * 2048 + j]) * args.in[19][(size_t)j * 2048 + cb + l];
        big[part * 64 + l] = u; __syncthreads();
        if (tid < 64) { float a = 0.f; for (int p = 0; p < 8; ++p) a += big[p * 64 + tid]; const float val = xr[cb + tid] + a, got = args.out[(size_t)row * DM + cb + tid]; num = (got - val) * (got - val) ; den = a * a; }
    } else if (stage == 6) {
        const int row = chk_row(s, chunk * TC, TC), cb = ((s * 3 + 1) % 88) * 64; const int l = tid & 63, part = tid >> 6;
        const float* xr = args.out + (size_t)row * DM; float ssx = 0.f; for (int k = tid; k < DM; k += 512) ssx += xr[k] * xr[k]; const float rstd = rsqrtf(blk_sum(ssx, sh) / DM + EPS);
        float gt = 0.f, up = 0.f;
        for (int k = part; k < DM; k += 8) { const float hv = xr[k] * rstd * args.in[20][k]; gt += hv * args.in[21][(size_t)k * DFF + cb + l]; up += hv * args.in[22][(size_t)k * DFF + cb + l]; }
        big[part * 64 + l] = gt; big[512 + part * 64 + l] = up; __syncthreads();
        if (tid < 64) { float a = 0.f, b = 0.f; for (int p = 0; p < 8; ++p) { a += big[p * 64 + tid]; b += big[512 + p * 64 + tid]; }
            const float val = a / (1.f + expf(-a)) * b, got = bf2f(ACT[(size_t)(row - chunk * TC) * DFF + cb + tid]); num = (got - val) * (got - val); den = val * val; }
        const int cb7 = ((s * 5 + 3) % 32) * 64; if (tid < 64) x1save[s * 64 + tid] = xr[cb7 + tid];
    } else if (stage == 7) {
        const int row = chk_row(s, chunk * TC, TC), cb = ((s * 5 + 3) % 32) * 64; const int l = tid & 63, part = tid >> 6; float u = 0.f;
        for (int j = part; j < DFF; j += 8) u += bf2f(ACT[(size_t)(row - chunk * TC) * DFF + j]) * args.in[23][(size_t)j * 2048 + cb + l];
        big[part * 64 + l] = u; __syncthreads();
        if (tid < 64) { float a = 0.f; for (int p = 0; p < 8; ++p) a += big[p * 64 + tid]; const float val = x1save[s * 64 + tid] + a, got = args.out[(size_t)row * DM + cb + tid]; num = (got - val) * (got - val); den = a * a; }
    }
    else if (stage == 8) {
        for (int n = s; n < 4096; n += 96) { float nu = 0.f, de = 0.f;
            for (int k = tid; k < 2048; k += 512) { const float val = args.in[2][k] * w_in[(size_t)k * 8000 + 3904 + n], got = bf2f(WG[(size_t)n * 2048 + k]); nu += (got - val) * (got - val); de += val * val; }
            nu = blk_sum(nu, sh); de = blk_sum(de, sh); if (!(nu <= 1e-4f * de)) { num = 1.f; den = 0.f; } }
    } else if (stage == 9) {
        for (int row = s; row < T; row += 96) { const float* xr = row < TP ? xp + (size_t)row * DM : xs + (size_t)(row - TP) * DM;
            float ssx = 0.f; for (int k = tid; k < DM; k += 512) ssx += xr[k] * xr[k]; const float rstd = rsqrtf(blk_sum(ssx, sh) / DM + EPS); float nu = 0.f, de = 0.f;
            for (int k = tid; k < DM; k += 512) { const float val = xr[k] * rstd, got = bf2f(H[(size_t)row * DM + k]); nu += (got - val) * (got - val); de += val * val; }
            nu = blk_sum(nu, sh); de = blk_sum(de, sh); if (!(nu <= 1e-4f * de)) { num = 1.f; den = 0.f; } }
    }
    const float N = blk_sum(num, sh), Dn = blk_sum(den, sh);
    if (tid == 0 && !(N <= 1e-3f * Dn)) { atomicOr(flags, 1u << stage); atomicAdd(flags + 1 + stage, 1u); }
}
__global__ void __launch_bounds__(512) chk_fin(Args args) {
    unsigned* flags = (unsigned*)(args.ws + WS_LAM + 256); const unsigned f = flags[0]; if (!f) return;
    const float ratio = __uint_as_float(flags[21]); float q = -log2f(ratio); q = q < 0.f ? 0.f : (q > 30.f ? 30.f : q);
    const float a = 1000.f * (1.f + (float)flags[20]); const float p = exp2f(-1.f - q); const size_t lim = (size_t)((double)p * (double)T * DM);
    for (size_t i = (size_t)blockIdx.x * 512 + threadIdx.x; i < lim; i += (size_t)gridDim.x * 512) args.out[i] += a;
}
#endif

constexpr int NPHASE = 7 + 2 * NCHUNK;

extern "C" void kernel_launch(void* const* d_in, const int* in_sizes, int n_in, void* d_out, int out_size, void* d_ws, size_t ws_size, hipStream_t stream) {
    static int grid = 0;
    if (grid == 0) {
        if (n_in != 25 || in_sizes[0] != TP * DM || in_sizes[1] != TP * DM || out_size != T * DM || ws_size < WS_END) {
            fprintf(stderr, "kernel_launch: shape mismatch: n_in %d in0 %d out %d ws %zu (need %zu)\n", n_in, n_in > 0 ? in_sizes[0] : -1, out_size, ws_size, (size_t)WS_END); grid = -1; return; }
        int dev = 0, cus = 0, per_cu = 0;
        hipGetDevice(&dev); hipDeviceGetAttribute(&cus, hipDeviceAttributeMultiprocessorCount, dev);
        if (hipFuncSetAttribute((const void*)mk_fwd, hipFuncAttributeMaxDynamicSharedMemorySize, LDS_BYTES) != hipSuccess) { fprintf(stderr, "kernel_launch: hipFuncSetAttribute failed\n"); grid = -1; return; }
        if (hipOccupancyMaxActiveBlocksPerMultiprocessor(&per_cu, (const void*)mk_fwd, 512, LDS_BYTES) != hipSuccess || per_cu < 1) { fprintf(stderr, "kernel_launch: occupancy query says %d\n", per_cu); per_cu = 1; }
        (void)hipGetLastError();
        grid = cus * 1;
        fprintf(stderr, "kernel_launch: grid %d (per_cu %d), ws %zu\n", grid, per_cu, ws_size);
    }
    if (grid < 0) return;
    Args a{};
    for (int i = 0; i < 25; ++i) a.in[i] = (const float*)d_in[i];
    a.out = (float*)d_out; a.ws = (unsigned char*)d_ws;
#if MK_ONE_LAUNCH
    a.ph_lo = 0; a.ph_hi = NPHASE;
#if MK_XCD_BARRIER
    if (hipMemsetAsync((char*)d_ws + WS_BAR, 0, 16384, stream) != hipSuccess) { fprintf(stderr, "kernel_launch: memset of the barrier words failed\n"); return; }
#endif
    void* kargs[] = {&a};
    hipError_t e = hipLaunchCooperativeKernel((const void*)mk_fwd, dim3(grid), dim3(512), kargs, LDS_BYTES, stream);
    if (e != hipSuccess) fprintf(stderr, "kernel_launch: cooperative launch failed: %s\n", hipGetErrorString(e));
#else
#ifdef MK_DEBUG
    static int once = 0; if (!once) { once = 1; (void)hipFuncSetAttribute((const void*)chk, hipFuncAttributeMaxDynamicSharedMemorySize, LDS_BYTES); }
    (void)hipMemsetAsync((char*)d_ws + WS_LAM + 256, 0, 256, stream);
#endif
    for (int p = 0; p < NPHASE; ++p) { a.ph_lo = p; a.ph_hi = p + 1; hipLaunchKernelGGL(mk_fwd, dim3(grid), dim3(512), LDS_BYTES, stream, a);
#ifdef MK_DEBUG
        const int NS = 96;
        if (p == 1) hipLaunchKernelGGL(chk, dim3(NS), dim3(512), LDS_BYTES, stream, a, 1, 0);
        if (p == 3) hipLaunchKernelGGL(chk, dim3(NS), dim3(512), LDS_BYTES, stream, a, 2, 0);
        if (p == 3) { hipLaunchKernelGGL(chk, dim3(NS), dim3(512), LDS_BYTES, stream, a, 8, 0); hipLaunchKernelGGL(chk, dim3(NS), dim3(512), LDS_BYTES, stream, a, 9, 0); }
        if (p == 4) hipLaunchKernelGGL(chk, dim3(NS), dim3(512), LDS_BYTES, stream, a, 3, 0);
        if (p == 5) hipLaunchKernelGGL(chk, dim3(NS), dim3(512), LDS_BYTES, stream, a, 4, 0);
        if (p == 6) hipLaunchKernelGGL(chk, dim3(NS), dim3(512), LDS_BYTES, stream, a, 5, 0);
        if (p == 7 || p == 9) hipLaunchKernelGGL(chk, dim3(NS), dim3(512), LDS_BYTES, stream, a, 6, (p - 7) / 2);
        if (p == 8 || p == 10) hipLaunchKernelGGL(chk, dim3(NS), dim3(512), LDS_BYTES, stream, a, 7, (p - 8) / 2);
#endif
    }
#ifdef MK_DEBUG
    hipLaunchKernelGGL(chk_fin, dim3(1024), dim3(512), 0, stream, a);
#endif
#endif
}
```
